# Optimizing an MI355X kernel written in HIP

```python
import math
import jax, jax.numpy as jnp
from jax import lax
import numpy as np

D_MODEL = 1024
BATCH = 2
SEQ = 16384
DEPTH = 1

N_META = 16
GRID_W = 64
HEAD_DIM = 128
N_Q_HEADS = 4
N_KV_HEADS = 2
Q_GROUP = N_Q_HEADS // N_KV_HEADS
ATTN_W = N_Q_HEADS * HEAD_DIM
KV_W = N_KV_HEADS * HEAD_DIM
N_FOURIER_GROUPS = 4
FOURIER_GROUP_W = 128
FOURIER_W = N_FOURIER_GROUPS * FOURIER_GROUP_W
MIX_W = ATTN_W + FOURIER_W
IN_PROJ_W = ATTN_W + 2 * KV_W + FOURIER_W
D_FF = 4 * D_MODEL
Q_BLOCK = 128
ROPE_THETA = 10000.0
ROPE_AXIS_DIM = HEAD_DIM // 2
RMS_EPS = 1e-6

kernel_name = 'hymba_axial_gqa_fnet_encoder_block'


def rms_norm(x, g):
    xf = x.astype(jnp.float32)
    y = xf * lax.rsqrt(jnp.mean(xf * xf, axis=-1, keepdims=True) + RMS_EPS)
    return (y * g.astype(jnp.float32)).astype(x.dtype)


def grid_positions(n_tok):
    rows_count = n_tok // GRID_W
    real_row = jnp.repeat(jnp.arange(rows_count, dtype=jnp.float32), GRID_W)
    real_col = jnp.tile(jnp.arange(GRID_W, dtype=jnp.float32), rows_count)
    meta_row = jnp.full((N_META,), -1.0, dtype=jnp.float32)
    meta_col = jnp.arange(N_META, dtype=jnp.float32)
    return jnp.concatenate([meta_row, real_row]), jnp.concatenate([meta_col, real_col])


def rope_angles(pos):
    inv_freq = ROPE_THETA ** (-jnp.arange(0, ROPE_AXIS_DIM, 2, dtype=jnp.float32) / ROPE_AXIS_DIM)
    ang = pos[:, None] * inv_freq[None, :]
    return jnp.cos(ang), jnp.sin(ang)


def _rotate(x, cos, sin):
    c = cos[None, :, None, :]
    s = sin[None, :, None, :]
    x1, x2 = jnp.split(x, 2, axis=-1)
    return jnp.concatenate([x1 * c - x2 * s, x2 * c + x1 * s], axis=-1)


def axial_rope(x, cos_r, sin_r, cos_c, sin_c):
    xf = x.astype(jnp.float32)
    xr = _rotate(xf[..., :ROPE_AXIS_DIM], cos_r, sin_r)
    xc = _rotate(xf[..., ROPE_AXIS_DIM:], cos_c, sin_c)
    return jnp.concatenate([xr, xc], axis=-1).astype(x.dtype)


def block_attention(q, k, v):
    b, l, _, d = q.shape
    scale = 1.0 / math.sqrt(d)
    qt = q.reshape(b, l, N_KV_HEADS, Q_GROUP, d).transpose(0, 2, 3, 1, 4)
    kt = k.transpose(0, 2, 1, 3)
    vt = v.transpose(0, 2, 1, 3)

    def attend(qb):
        s = jnp.einsum('bkgqd,bksd->bkgqs', qb, kt).astype(jnp.float32) * scale
        p = jax.nn.softmax(s, axis=-1).astype(vt.dtype)
        return jnp.einsum('bkgqs,bksd->bkgqd', p, vt)

    out_meta = attend(qt[:, :, :, :N_META])
    n_real = l - N_META
    nb = n_real // Q_BLOCK
    qr = qt[:, :, :, N_META:].reshape(b, N_KV_HEADS, Q_GROUP, nb, Q_BLOCK, d)
    qr = jnp.moveaxis(qr, 3, 0)
    out_real = lax.map(attend, qr)
    out_real = jnp.moveaxis(out_real, 0, 3).reshape(b, N_KV_HEADS, Q_GROUP, n_real, d)
    out = jnp.concatenate([out_meta, out_real], axis=3)
    return out.transpose(0, 3, 1, 2, 4).reshape(b, l, ATTN_W)


def fourier_mix(u, w_f):
    b, l, _ = u.shape
    ug = u.reshape(b, l, N_FOURIER_GROUPS, FOURIER_GROUP_W).astype(jnp.float32)
    f = jnp.fft.fft2(ug, axes=(1, 3), norm='ortho').real.astype(u.dtype)
    y = jnp.einsum('blgc,gcd->blgd', f, w_f)
    return y.reshape(b, l, FOURIER_W)


def setup_inputs(seed: int = 0) -> dict:
    key = jax.random.key(seed)
    ks = jax.random.split(key, 16)
    f32 = jnp.float32

    def gain(k, shape):
        return 1.0 + 0.02 * jax.random.normal(k, shape, f32)

    x = jax.random.normal(ks[0], (BATCH, SEQ, D_MODEL), f32)
    meta_tokens = jax.random.normal(ks[1], (N_META, D_MODEL), f32)
    g_mix = gain(ks[2], (DEPTH, D_MODEL))
    w_in = jax.random.normal(ks[3], (DEPTH, D_MODEL, IN_PROJ_W), f32) * D_MODEL ** -0.5
    g_q = gain(ks[4], (DEPTH, HEAD_DIM))
    g_k = gain(ks[5], (DEPTH, HEAD_DIM))
    w_fourier = jax.random.normal(ks[6], (DEPTH, N_FOURIER_GROUPS, FOURIER_GROUP_W, FOURIER_GROUP_W), f32) * FOURIER_GROUP_W ** -0.5
    g_attn_out = gain(ks[7], (DEPTH, ATTN_W))
    g_fourier_out = gain(ks[8], (DEPTH, FOURIER_W))
    w_out = jax.random.normal(ks[9], (DEPTH, MIX_W, D_MODEL), f32) * MIX_W ** -0.5
    g_mlp = gain(ks[10], (DEPTH, D_MODEL))
    w_up = jax.random.normal(ks[11], (DEPTH, D_MODEL, D_FF), f32) * D_MODEL ** -0.5
    w_down = jax.random.normal(ks[12], (DEPTH, D_FF, D_MODEL), f32) * D_FF ** -0.5
    g_final = gain(ks[13], (D_MODEL,))
    return {'x': x, 'meta_tokens': meta_tokens, 'g_mix': g_mix, 'w_in': w_in, 'g_q': g_q, 'g_k': g_k,
            'w_fourier': w_fourier, 'g_attn_out': g_attn_out, 'g_fourier_out': g_fourier_out, 'w_out': w_out,
            'g_mlp': g_mlp, 'w_up': w_up, 'w_down': w_down, 'g_final': g_final}


def reference(x, meta_tokens, g_mix, w_in, g_q, g_k, w_fourier, g_attn_out, g_fourier_out, w_out,
              g_mlp, w_up, w_down, g_final):
    b, n_tok, d = x.shape
    meta = jnp.broadcast_to(meta_tokens[None].astype(x.dtype), (b, N_META, d))
    h = jnp.concatenate([meta, x], axis=1)
    l = h.shape[1]

    row, col = grid_positions(n_tok)
    cos_r, sin_r = rope_angles(row)
    cos_c, sin_c = rope_angles(col)

    for i in range(DEPTH):
        hn = rms_norm(h, g_mix[i])
        proj = hn @ w_in[i]
        q = proj[..., :ATTN_W].reshape(b, l, N_Q_HEADS, HEAD_DIM)
        k = proj[..., ATTN_W:ATTN_W + KV_W].reshape(b, l, N_KV_HEADS, HEAD_DIM)
        v = proj[..., ATTN_W + KV_W:ATTN_W + 2 * KV_W].reshape(b, l, N_KV_HEADS, HEAD_DIM)
        u = proj[..., ATTN_W + 2 * KV_W:]
        q = axial_rope(rms_norm(q, g_q[i]), cos_r, sin_r, cos_c, sin_c)
        k = axial_rope(rms_norm(k, g_k[i]), cos_r, sin_r, cos_c, sin_c)
        attn = block_attention(q, k, v)
        four = fourier_mix(u, w_fourier[i])
        mixed = jnp.concatenate([rms_norm(attn, g_attn_out[i]), rms_norm(four, g_fourier_out[i])], axis=-1)
        h = h + mixed @ w_out[i]
        m = rms_norm(h, g_mlp[i])
        h = h + jnp.square(jax.nn.relu(m @ w_up[i])) @ w_down[i]

    return rms_norm(h, g_final)[:, N_META:]
```

```cpp
#include <hip/hip_runtime.h>
#include <hip/hip_bf16.h>
#include <cstdio>
#include <cstdint>

constexpr int BATCH = 2, SEQ = 16384, DM = 1024, NMETA = 16, LTOK = SEQ + NMETA, HQ = 4, HKV = 2, DFF = 4096, NPROJ = 1536;
constexpr int MR = BATCH * SEQ;
constexpr int MPAD = MR + 256;
constexpr int LPA = 16512;
constexpr int FN1 = 80, FN2 = 205;
constexpr float RMS_EPS = 1e-6f;
namespace pg8 {
#define PG8_LAS __attribute__((address_space(3)))
typedef unsigned short bf16_t;
typedef short bf16x8 __attribute__((ext_vector_type(8)));
typedef float f32x4 __attribute__((ext_vector_type(4)));
typedef unsigned u32x4 __attribute__((ext_vector_type(4)));
constexpr int BM = 256, BK = 64, HALF = 128, HTB = HALF * BK * 2  , STAGE_BYTES = 8 * HTB, NXCD = 8, WGM = 8;

__host__ __device__ __forceinline__ int lds_byte(int r, int c) { const int st = (r >> 4) * 2 + (c >> 5), rr = r & 15, cc = c & 31, ob = rr * 64 + cc * 2; return st * 1024 + (ob ^ (((ob >> 9) & 1) << 5)); }
__host__ __device__ __forceinline__ void stage_rc(int b, int& R, int& C) { const int st = b / 1024, sb = b % 1024, swz = sb ^ (((sb >> 9) & 1) << 5); R = (st >> 1) * 16 + swz / 64; C = (st & 1) * 32 + (swz % 64) / 2; }
__host__ __device__ __forceinline__ int perm32(int rho) { const int n = rho >> 4, i = rho & 15; return 8 * (i >> 2) + 4 * n + (i & 3); }

struct Unit { int pm, pn; };
struct Gemm { const bf16_t* A; const bf16_t* Bt; int M, N, K; };

struct StaticOrder {
    int nM, nN, nwg, G, c;
    __host__ __device__ void init(int M, int N, int G_, int c_) { nM = M / BM; nN = N / BM; nwg = nM * nN; G = G_; c = c_; }
    __host__ __device__ bool next(int i, Unit& u) const {
        const long L = (long)i * G + c; if (L >= nwg) return false;
        int wgid = (int)L; { const int q = nwg / NXCD, r = nwg % NXCD, xcd = wgid % NXCD, off = wgid / NXCD; wgid = (xcd < r ? xcd * (q + 1) : r * (q + 1) + (xcd - r) * q) + off; }
        const int nig = WGM * nN, gid = wgid / nig, fm = gid * WGM, gsz = (nM - fm) < WGM ? (nM - fm) : WGM;
        u.pm = fm + ((wgid % nig) % gsz); u.pn = (wgid % nig) / gsz; return true;
    }
    __device__ __forceinline__ void a_ready(const Unit&) const {}
    __device__ __forceinline__ void done(const Unit&) const {}
};


__device__ __forceinline__ unsigned cvt_pk_bf16(float lo, float hi) { unsigned r; asm volatile("v_cvt_pk_bf16_f32 %0, %1, %2" : "=v"(r) : "v"(lo), "v"(hi)); return r; }
typedef unsigned u32x2 __attribute__((ext_vector_type(2)));
typedef _Float16 f16x4 __attribute__((ext_vector_type(4)));

struct InProjOrder {
    StaticOrder so;
    __device__ void init(int G_, int c_) { so.init(MR, NPROJ, G_, c_); }
    __device__ bool next(int i, Unit& u) const {
        if (so.next(i, u)) return true;
        const long L = (long)i * so.G + so.c - so.nwg; if (L < 0 || L >= 4) return false;
        u.pm = 128; u.pn = 2 + (int)L; return true;
    }
    __device__ __forceinline__ void a_ready(const Unit&) const {}
    __device__ __forceinline__ void done(const Unit&) const {}
};

struct EpiInProj {
    static constexpr bool PERM = false, AFTER_DRAIN = false, MIDK = false;
    float* qkraw; bf16_t* V; _Float16* U;
    __device__ __forceinline__ void operator()(const f32x4 (&acc)[2][2][4][2], const Unit& u, int wr, int wc, int fr, int fq) const {
        const bool meta = (u.pm == 128);
#pragma unroll
        for (int ai = 0; ai < 2; ++ai)
#pragma unroll
            for (int m = 0; m < 4; ++m) {
                const int rl = ai * HALF + wr * 64 + m * 16 + fr, grow = u.pm * BM + rl;
                const bool valid = !meta || rl < NMETA;
                const int b = grow >> 14, t = grow & (SEQ - 1);
                if (u.pn <= 2) {
                    if (valid) { float* p = qkraw + (size_t)grow * 768 + u.pn * BM + wc * 32 + 4 * fq;
#pragma unroll
                        for (int bj = 0; bj < 2; ++bj)
#pragma unroll
                            for (int n = 0; n < 2; ++n) *(f32x4*)(p + bj * HALF + n * 16) = acc[ai][bj][m][n]; }
                } else if (u.pn == 3) {
#pragma unroll
                    for (int bj = 0; bj < 2; ++bj)
#pragma unroll
                        for (int n = 0; n < 2; ++n) { const f32x4 v = acc[ai][bj][m][n]; u32x2 w; w.x = cvt_pk_bf16(v[0], v[1]); w.y = cvt_pk_bf16(v[2], v[3]);
                            const int d = wc * 32 + n * 16 + 4 * fq;
                            if (!meta) *(u32x2*)(V + ((size_t)(b * HKV + bj) * LPA + 64 + t) * 128 + d) = w;
                            else if (valid) { *(u32x2*)(V + ((size_t)(0 * HKV + bj) * LPA + rl) * 128 + d) = w; *(u32x2*)(V + ((size_t)(1 * HKV + bj) * LPA + rl) * 128 + d) = w; } }
                } else {
#pragma unroll
                    for (int bj = 0; bj < 2; ++bj)
#pragma unroll
                        for (int n = 0; n < 2; ++n) { const f32x4 v = acc[ai][bj][m][n]; f16x4 h; h[0] = (_Float16)v[0]; h[1] = (_Float16)v[1]; h[2] = (_Float16)v[2]; h[3] = (_Float16)v[3];
                            const int cu = (u.pn - 4) * BM + bj * HALF + wc * 32 + n * 16 + 4 * fq;
                            if (!meta) *(f16x4*)(U + ((size_t)b * LTOK + NMETA + t) * 512 + cu) = h;
                            else if (valid) { *(f16x4*)(U + ((size_t)0 * LTOK + rl) * 512 + cu) = h; *(f16x4*)(U + ((size_t)1 * LTOK + rl) * 512 + cu) = h; } }
                }
            }
    }
};

struct EpiOutProj {
    static constexpr bool PERM = false, AFTER_DRAIN = false, MIDK = true;
    const float* x; float* H1; bf16_t* H1B; const float* rssf; float* rssm; const PG8_LAS float* tab;
    __device__ __forceinline__ void mid(f32x4 (&acc)[2][2][4][2], int ui, int wr, int fr) const {
        const PG8_LAS float* tp = tab + ui * BM + wr * 64 + fr;
#pragma unroll
        for (int ai = 0; ai < 2; ++ai)
#pragma unroll
            for (int m = 0; m < 4; ++m) { const float ratio = tp[ai * HALF + m * 16];
#pragma unroll
                for (int bj = 0; bj < 2; ++bj)
#pragma unroll
                    for (int n = 0; n < 2; ++n) acc[ai][bj][m][n] = acc[ai][bj][m][n] * ratio; }
    }
    __device__ __forceinline__ void operator()(const f32x4 (&acc)[2][2][4][2], const Unit& u, int wr, int wc, int fr, int fq) const {
        const int col0 = u.pn * BM + wc * 32 + 4 * fq;
#pragma unroll
        for (int ai = 0; ai < 2; ++ai)
#pragma unroll
            for (int m = 0; m < 4; ++m) { const int row = u.pm * BM + ai * HALF + wr * 64 + m * 16 + fr; const size_t off = (size_t)row * DM + col0;
                const float rf = 1.0f / sqrtf(rssf[row] * (1.0f / 512.0f) + RMS_EPS); float ss = 0.f;
#pragma unroll
                for (int bj = 0; bj < 2; ++bj)
#pragma unroll
                    for (int n = 0; n < 2; ++n) { const f32x4 xr = *(const f32x4*)(x + off + bj * HALF + n * 16); const f32x4 v = acc[ai][bj][m][n] * rf + xr;
                        *(f32x4*)(H1 + off + bj * HALF + n * 16) = v; u32x2 w; w.x = cvt_pk_bf16(v[0], v[1]); w.y = cvt_pk_bf16(v[2], v[3]); *(u32x2*)(H1B + off + bj * HALF + n * 16) = w;
                        ss += (v[0] * v[0] + v[1] * v[1]) + (v[2] * v[2] + v[3] * v[3]); }
                ss += __shfl_xor(ss, 16); ss += __shfl_xor(ss, 32);
                if (fq == 0) unsafeAtomicAdd(rssm + row, ss);
                asm volatile("" ::: "memory"); }
    }
};

struct EpiUp {
    static constexpr bool PERM = true, AFTER_DRAIN = false, MIDK = false;
    bf16_t* HID; const float* rssm;
    __device__ __forceinline__ void operator()(const f32x4 (&acc)[2][2][4][2], const Unit& u, int wr, int wc, int fr, int fq) const {
        const int col0 = u.pn * BM + wc * 32 + 8 * fq;
#pragma unroll
        for (int ai = 0; ai < 2; ++ai)
#pragma unroll
            for (int m = 0; m < 4; ++m) { const int row = u.pm * BM + ai * HALF + wr * 64 + m * 16 + fr; bf16_t* rowp = HID + (size_t)row * DFF + col0;
                const float rs = 1.0f / sqrtf(rssm[row] * (1.0f / 1024.0f) + RMS_EPS);
#pragma unroll
                for (int bj = 0; bj < 2; ++bj) { f32x4 v0 = acc[ai][bj][m][0] * rs, v1 = acc[ai][bj][m][1] * rs;
#pragma unroll
                    for (int e = 0; e < 4; ++e) { const float a = fmaxf(v0[e], 0.f), b = fmaxf(v1[e], 0.f); v0[e] = a * a; v1[e] = b * b; }
                    u32x4 w; w.x = cvt_pk_bf16(v0[0], v0[1]); w.y = cvt_pk_bf16(v0[2], v0[3]); w.z = cvt_pk_bf16(v1[0], v1[1]); w.w = cvt_pk_bf16(v1[2], v1[3]);
                    *(u32x4*)(rowp + bj * HALF) = w; } }
    }
};

struct EpiDown {
    static constexpr bool PERM = false, AFTER_DRAIN = false, MIDK = false;
    const float* H1; float* out; float* rss2;
    __device__ __forceinline__ void operator()(const f32x4 (&acc)[2][2][4][2], const Unit& u, int wr, int wc, int fr, int fq) const {
        const int col0 = u.pn * BM + wc * 32 + 4 * fq;
#pragma unroll
        for (int ai = 0; ai < 2; ++ai)
#pragma unroll
            for (int m = 0; m < 4; ++m) { const int row = u.pm * BM + ai * HALF + wr * 64 + m * 16 + fr; const size_t off = (size_t)row * DM + col0; float ss = 0.f;
#pragma unroll
                for (int bj = 0; bj < 2; ++bj)
#pragma unroll
                    for (int n = 0; n < 2; ++n) { const f32x4 hr = *(const f32x4*)(H1 + off + bj * HALF + n * 16); const f32x4 v = acc[ai][bj][m][n] + hr;
                        *(f32x4*)(out + off + bj * HALF + n * 16) = v; ss += (v[0] * v[0] + v[1] * v[1]) + (v[2] * v[2] + v[3] * v[3]); }
                ss += __shfl_xor(ss, 16); ss += __shfl_xor(ss, 32);
                if (fq == 0) unsafeAtomicAdd(rss2 + row, ss);
                asm volatile("" ::: "memory"); }
    }
};

template <class Epi, class Sched, bool ALIGN_EPI = false, bool SP2 = false>
__device__ __forceinline__ void gemm_phase(PG8_LAS unsigned char* lds, const Gemm g, const Sched& S, const Epi& E) {
    const int tid = threadIdx.x, wid = __builtin_amdgcn_readfirstlane(tid >> 6), lane = tid & 63, wr = wid >> 2, wc = wid & 3, fr = lane & 15, fq = lane >> 4;
    const int K = g.K, nt = K / BK;
    unsigned voffA[2], voffB[2];
#pragma unroll
    for (int i = 0; i < 2; ++i) { int R, C; stage_rc(tid * 16 + i * 8192, R, C); const int Rb = Epi::PERM ? ((R & ~31) + perm32(R & 31)) : R;
        voffA[i] = (unsigned)(R * K + C) * 2u; voffB[i] = (unsigned)(Rb * K + C) * 2u; }
    const size_t kstep = (size_t)(BK * 2);
    const size_t hstep = (size_t)HALF * K * 2;
    const size_t tstep = 2 * hstep;
    const unsigned ldsw = (unsigned)wid * 1024u;
    const int aoff = lds_byte(wr * 64 + fr, fq * 8), boff = lds_byte(wc * 32 + fr, fq * 8);
#define PG8_SA(b, h) (((b) * 2 + (h)) * HTB)
#define PG8_SB(b, h) ((4 + (b) * 2 + (h)) * HTB)
#define PG8_STAGE(bufoff, gbase, voff) do { _Pragma("unroll") for (int _i = 0; _i < 2; ++_i) \
        __builtin_amdgcn_global_load_lds((const unsigned*)((const char*)(gbase) + (voff)[_i]), (PG8_LAS unsigned*)(lds + (bufoff) + ldsw + _i * 8192), 16, 0, 0); } while (0)
#define PG8_LDA(dst, b, h) do { _Pragma("unroll") for (int m = 0; m < 4; ++m) _Pragma("unroll") for (int k = 0; k < 2; ++k) dst[m][k] = *(const PG8_LAS bf16x8*)(lds + PG8_SA(b, h) + aoff + m * 2048 + k * 1024); } while (0)
#define PG8_LDB(dst, b, h) do { _Pragma("unroll") for (int n = 0; n < 2; ++n) _Pragma("unroll") for (int k = 0; k < 2; ++k) dst[n][k] = *(const PG8_LAS bf16x8*)(lds + PG8_SB(b, h) + boff + n * 2048 + k * 1024); } while (0)
#define PG8_MMA(ai, bj, At, Bt) do { __builtin_amdgcn_s_setprio(1); _Pragma("unroll") for (int m = 0; m < 4; ++m) _Pragma("unroll") for (int n = 0; n < 2; ++n) _Pragma("unroll") for (int k = 0; k < 2; ++k) \
        acc[ai][bj][m][n] = __builtin_amdgcn_mfma_f32_16x16x32_bf16(Bt[n][k], At[m][k], acc[ai][bj][m][n], 0, 0, 0); __builtin_amdgcn_s_setprio(0); } while (0)
#define PG8_WAIT_V(n) asm volatile("s_waitcnt vmcnt(" #n ")" ::: "memory")
#define PG8_WAIT_L(n) asm volatile("s_waitcnt lgkmcnt(" #n ")" ::: "memory")
#define PG8_BAR __builtin_amdgcn_s_barrier()
#define PG8_SCHED __builtin_amdgcn_sched_barrier(0)
    Unit cur, nxt; int ui = 0;
    if (!S.next(0, cur)) return;
    f32x4 acc[2][2][4][2];
#pragma unroll
    for (int a = 0; a < 2; ++a)
#pragma unroll
        for (int b = 0; b < 2; ++b)
#pragma unroll
            for (int m = 0; m < 4; ++m)
#pragma unroll
                for (int n = 0; n < 2; ++n) acc[a][b][m][n] = (f32x4){0.f, 0.f, 0.f, 0.f};
    bf16x8 At[4][2], B0[2][2], B1[2][2];
    const char* cA = (const char*)g.A + (size_t)cur.pm * tstep; const char* cB = (const char*)g.Bt + (size_t)cur.pn * tstep;
    S.a_ready(cur);
    if constexpr (SP2) {
        PG8_STAGE(PG8_SB(0, 0), cB, voffB); PG8_STAGE(PG8_SB(0, 1), cB + hstep, voffB); PG8_STAGE(PG8_SA(0, 0), cA, voffA); PG8_STAGE(PG8_SA(0, 1), cA + hstep, voffA);
        if (wr == 1) PG8_BAR;
        PG8_WAIT_V(2); PG8_BAR;
        PG8_STAGE(PG8_SB(1, 0), cB + kstep, voffB); PG8_STAGE(PG8_SA(1, 0), cA + kstep, voffA); PG8_STAGE(PG8_SB(1, 1), cB + hstep + kstep, voffB);
        PG8_WAIT_V(6); PG8_BAR;
    } else {
        PG8_STAGE(PG8_SB(0, 0), cB, voffB); PG8_STAGE(PG8_SA(0, 0), cA, voffA); PG8_STAGE(PG8_SB(0, 1), cB + hstep, voffB); PG8_STAGE(PG8_SA(0, 1), cA + hstep, voffA);
        if (wr == 1) PG8_BAR;
        PG8_WAIT_V(4); PG8_BAR;
        PG8_STAGE(PG8_SB(1, 0), cB + kstep, voffB); PG8_STAGE(PG8_SA(1, 0), cA + kstep, voffA); PG8_STAGE(PG8_SB(1, 1), cB + hstep + kstep, voffB);
        PG8_WAIT_V(6); PG8_BAR;
    }
    for (;;) {
        const bool has_next = S.next(ui + 1, nxt);
        const char* nA = has_next ? (const char*)g.A + (size_t)nxt.pm * tstep : cA; const char* nB = has_next ? (const char*)g.Bt + (size_t)nxt.pn * tstep : cB;
        for (int t = 0; t < nt; t += 2) {
            const bool last = (t == nt - 2);
            if constexpr (Epi::MIDK) { if (t == (nt >> 1)) E.mid(acc, ui, wr, fr); }
            const char* a1 = cA + (size_t)(t + 1) * kstep;
            const char* a2 = last ? nA : cA + (size_t)(t + 2) * kstep; const char* b2 = last ? nB : cB + (size_t)(t + 2) * kstep;
            const char* a3 = a2 + kstep; const char* b3 = b2 + kstep;
            if (last && has_next) S.a_ready(nxt);
            if constexpr (SP2) {
            PG8_LDB(B0, 0, 0); PG8_LDB(B1, 0, 1); PG8_SCHED; PG8_LDA(At, 0, 0); PG8_STAGE(PG8_SA(1, 1), a1 + hstep, voffA);
            PG8_WAIT_V(8); PG8_WAIT_L(0); PG8_BAR; PG8_MMA(0, 0, At, B0); PG8_MMA(0, 1, At, B1); PG8_BAR; PG8_SCHED;
            PG8_LDA(At, 0, 1); PG8_STAGE(PG8_SB(0, 0), b2, voffB); PG8_STAGE(PG8_SB(0, 1), b2 + hstep, voffB); PG8_STAGE(PG8_SA(0, 0), a2, voffA);
            PG8_WAIT_V(8); PG8_WAIT_L(0); PG8_BAR; PG8_MMA(1, 0, At, B0); PG8_MMA(1, 1, At, B1); PG8_BAR; PG8_SCHED;
            PG8_LDB(B0, 1, 0); PG8_LDB(B1, 1, 1); PG8_SCHED; PG8_LDA(At, 1, 0); PG8_STAGE(PG8_SA(0, 1), a2 + hstep, voffA);
            PG8_WAIT_V(8); PG8_WAIT_L(0); PG8_BAR; PG8_MMA(0, 0, At, B0); PG8_MMA(0, 1, At, B1); PG8_BAR; PG8_SCHED;
            PG8_LDA(At, 1, 1); PG8_STAGE(PG8_SB(1, 0), b3, voffB); PG8_STAGE(PG8_SB(1, 1), b3 + hstep, voffB); PG8_STAGE(PG8_SA(1, 0), a3, voffA);
            PG8_WAIT_V(8); PG8_WAIT_L(0); PG8_BAR; PG8_MMA(1, 0, At, B0); PG8_MMA(1, 1, At, B1); PG8_BAR; PG8_SCHED;
            } else {
            PG8_LDB(B0, 0, 0); PG8_SCHED; PG8_LDA(At, 0, 0); PG8_STAGE(PG8_SA(1, 1), a1 + hstep, voffA);
            PG8_WAIT_L(8); PG8_BAR; PG8_WAIT_L(0); PG8_MMA(0, 0, At, B0); PG8_BAR; PG8_SCHED;
            PG8_LDB(B1, 0, 1); PG8_STAGE(PG8_SB(0, 0), b2, voffB);
            PG8_BAR; PG8_WAIT_L(0); PG8_MMA(0, 1, At, B1); PG8_BAR;
            PG8_LDA(At, 0, 1); PG8_STAGE(PG8_SA(0, 0), a2, voffA);
            PG8_BAR; PG8_WAIT_L(0); PG8_MMA(1, 0, At, B0); PG8_BAR; PG8_SCHED;
            PG8_STAGE(PG8_SB(0, 1), b2 + hstep, voffB);
            PG8_WAIT_V(6); PG8_BAR; PG8_MMA(1, 1, At, B1); PG8_BAR;
            PG8_LDB(B0, 1, 0); PG8_SCHED; PG8_LDA(At, 1, 0); PG8_STAGE(PG8_SA(0, 1), a2 + hstep, voffA);
            PG8_WAIT_L(8); PG8_BAR; PG8_WAIT_L(0); PG8_MMA(0, 0, At, B0); PG8_BAR; PG8_SCHED;
            PG8_LDB(B1, 1, 1); PG8_STAGE(PG8_SB(1, 0), b3, voffB);
            PG8_BAR; PG8_WAIT_L(0); PG8_MMA(0, 1, At, B1); PG8_BAR;
            PG8_LDA(At, 1, 1); PG8_STAGE(PG8_SA(1, 0), a3, voffA);
            PG8_BAR; PG8_WAIT_L(0); PG8_MMA(1, 0, At, B0); PG8_BAR; PG8_SCHED;
            PG8_STAGE(PG8_SB(1, 1), b3 + hstep, voffB);
            PG8_WAIT_V(6); PG8_BAR; PG8_MMA(1, 1, At, B1); PG8_BAR;
            }
        }
        if constexpr (ALIGN_EPI) { if (wr == 0) PG8_BAR; }
        if constexpr (!Epi::AFTER_DRAIN) { E(acc, cur, wr, wc, fr, fq); S.done(cur); }
        if (!has_next) break;
#pragma unroll
        for (int a = 0; a < 2; ++a)
#pragma unroll
            for (int b = 0; b < 2; ++b)
#pragma unroll
                for (int m = 0; m < 4; ++m)
#pragma unroll
                    for (int n = 0; n < 2; ++n) acc[a][b][m][n] = (f32x4){0.f, 0.f, 0.f, 0.f};
        cur = nxt; cA = nA; cB = nB; ++ui;
        if constexpr (ALIGN_EPI) { if (wr == 1) PG8_BAR; }
    }
    PG8_WAIT_V(0);
    if constexpr (!ALIGN_EPI) { if (wr == 0) PG8_BAR; }
    PG8_BAR;
    if constexpr (Epi::AFTER_DRAIN) { E.fused(acc, cur, wr, wc, fr, fq, lds, wid, lane); S.done(cur); }
#undef PG8_SA
#undef PG8_SB
#undef PG8_STAGE
#undef PG8_LDA
#undef PG8_LDB
#undef PG8_MMA
#undef PG8_WAIT_V
#undef PG8_WAIT_L
#undef PG8_BAR
#undef PG8_SCHED
}
}
namespace att {
using bf16x8 = __attribute__((ext_vector_type(8))) short;
using s16x4  = __attribute__((ext_vector_type(4))) short;
using f32x16 = __attribute__((ext_vector_type(16))) float;
using u32x4  = __attribute__((ext_vector_type(4))) unsigned;
constexpr int D = 128, NW = 8, QBLK = 32, KVBLK = 64, NT = 257;
constexpr float SCALE = 0.088388347648318440f;
constexpr float THR = 8.f;
constexpr int LDQ = D, LDK = D;
constexpr size_t SHM_V = KVBLK * D * 2, SHM_K = KVBLK * D * 2, SHM_ATTN = 2 * SHM_V + 2 * SHM_K + NW * 64 * 4;
#define KSWZ(row, colB) ((row) * 256 + ((colB) ^ (((row) & 7) << 4)))
#define SBAR() __builtin_amdgcn_sched_barrier(0)
__device__ __forceinline__ int crow(int r, int hi) { return (r & 3) + 8 * (r >> 2) + 4 * hi; }
__device__ __forceinline__ unsigned cvtpk(float lo, float hi) { unsigned r; asm volatile("v_cvt_pk_bf16_f32 %0, %1, %2" : "=v"(r) : "v"(lo), "v"(hi)); return r; }

__device__ __forceinline__ void partialSM(f32x16& p0, f32x16& p1, float& m_reg, float& mn, float& alpha) {
  constexpr float C = SCALE * 1.4426950408889634f;
  float pmax = p0[0]; for (int r = 1; r < 16; ++r) pmax = fmaxf(pmax, p0[r]); for (int r = 0; r < 16; ++r) pmax = fmaxf(pmax, p1[r]);
  { auto rr = __builtin_amdgcn_permlane32_swap(__float_as_uint(pmax), __float_as_uint(pmax), false, false);
    pmax = fmaxf(__uint_as_float(rr[0]), __uint_as_float(rr[1])); }
  if (__builtin_expect(__all(pmax - m_reg <= THR / SCALE), 1)) { mn = m_reg; alpha = 1.f; }
  else { mn = fmaxf(m_reg, pmax); alpha = __builtin_amdgcn_exp2f((m_reg - mn) * C); m_reg = mn; }
  float mnC = -mn * C;
  for (int r = 0; r < 16; ++r) p0[r] = fmaf(p0[r], C, mnC); for (int r = 0; r < 16; ++r) p1[r] = fmaf(p1[r], C, mnC);
  for (int r = 0; r < 16; ++r) p0[r] = __builtin_amdgcn_exp2f(p0[r]);
}
__device__ __forceinline__ void finishSM(f32x16& p0, f32x16& p1, float alpha, float& l_reg, bf16x8& pa0, bf16x8& pa1, bf16x8& pa2, bf16x8& pa3) {
  for (int r = 0; r < 16; ++r) p1[r] = __builtin_amdgcn_exp2f(p1[r]);
  float ps = 0; for (int r = 0; r < 16; ++r) ps += p0[r]; for (int r = 0; r < 16; ++r) ps += p1[r];
  { auto rr = __builtin_amdgcn_permlane32_swap(__float_as_uint(ps), __float_as_uint(ps), false, false);
    ps = __uint_as_float(rr[0]) + __uint_as_float(rr[1]); }
  l_reg = l_reg * alpha + ps;
#define PK4(P, BASE, OUT) do { unsigned a0 = cvtpk(P[BASE + 0], P[BASE + 1]), a1 = cvtpk(P[BASE + 2], P[BASE + 3]);   \
    unsigned b0 = cvtpk(P[BASE + 4], P[BASE + 5]), b1 = cvtpk(P[BASE + 6], P[BASE + 7]);                              \
    auto r0 = __builtin_amdgcn_permlane32_swap(a0, b0, false, false); auto r1 = __builtin_amdgcn_permlane32_swap(a1, b1, false, false); \
    u32x4 w = {r0[0], r1[0], r0[1], r1[1]}; OUT = *reinterpret_cast<bf16x8*>(&w); } while (0)
  PK4(p0, 0, pa0); PK4(p0, 8, pa1); PK4(p1, 0, pa2); PK4(p1, 8, pa3);
#undef PK4
}
__device__ __forceinline__ void qkt(f32x16& p0, f32x16& p1, const unsigned short* Ks, const bf16x8* qr, int r32, int hi) {
  p0 = f32x16{}; p1 = f32x16{};
  for (int d0 = 0; d0 < 8; ++d0) { int cb = (d0 * 16 + hi * 8) * 2;
    bf16x8 b0 = *reinterpret_cast<const bf16x8*>((const char*)Ks + KSWZ(r32, cb));
    bf16x8 b1 = *reinterpret_cast<const bf16x8*>((const char*)Ks + KSWZ(32 + r32, cb));
    p0 = __builtin_amdgcn_mfma_f32_32x32x16_bf16(b0, qr[d0], p0, 0, 0, 0);
    p1 = __builtin_amdgcn_mfma_f32_32x32x16_bf16(b1, qr[d0], p1, 0, 0, 0); }
}
__device__ __forceinline__ int v_st(int k, int c) { const int kk = (k & ~0xC) | ((k & 4) << 1) | ((k & 8) >> 1); return ((kk >> 3) * 4 + (c >> 5)) * 512 + ((kk & 7) * 32 + (c & 31)) * 2; }
__device__ __forceinline__ int v_rd_base(int lane) { return ((lane & 3) << 3) | (((lane >> 2) & 3) << 6) | (((lane >> 4) & 1) << 5) | (((lane >> 5) & 1) << 8); }
constexpr int v_rd_off(int d0, int ks, int half) { return d0 * 512 + ks * 4096 + half * 2048; }
template <int OFF> __device__ __forceinline__ s16x4 tr_read(int vb) {
  s16x4 r; asm volatile("ds_read_b64_tr_b16 %0, %1 offset:%2" : "=&v"(r) : "v"(vb), "i"(OFF) : "memory"); return r;
}
template <int D0> __device__ __forceinline__ void pv_one(f32x16& od, int vb, bf16x8 pa0, bf16x8 pa1, bf16x8 pa2, bf16x8 pa3) {
  const s16x4 l0 = tr_read<v_rd_off(D0, 0, 0)>(vb), h0 = tr_read<v_rd_off(D0, 0, 1)>(vb), l1 = tr_read<v_rd_off(D0, 1, 0)>(vb), h1 = tr_read<v_rd_off(D0, 1, 1)>(vb);
  const s16x4 l2 = tr_read<v_rd_off(D0, 2, 0)>(vb), h2 = tr_read<v_rd_off(D0, 2, 1)>(vb), l3 = tr_read<v_rd_off(D0, 3, 0)>(vb), h3 = tr_read<v_rd_off(D0, 3, 1)>(vb);
  asm volatile("s_waitcnt lgkmcnt(0)" ::: "memory"); SBAR();
#define PK(L, H) (bf16x8){L[0], L[1], L[2], L[3], H[0], H[1], H[2], H[3]}
  od = __builtin_amdgcn_mfma_f32_32x32x16_bf16(pa0, PK(l0, h0), od, 0, 0, 0);
  od = __builtin_amdgcn_mfma_f32_32x32x16_bf16(pa1, PK(l1, h1), od, 0, 0, 0);
  od = __builtin_amdgcn_mfma_f32_32x32x16_bf16(pa2, PK(l2, h2), od, 0, 0, 0);
  od = __builtin_amdgcn_mfma_f32_32x32x16_bf16(pa3, PK(l3, h3), od, 0, 0, 0);
#undef PK
}
__device__ __forceinline__ void pv_d0(f32x16* o, int vb, bf16x8 pa0, bf16x8 pa1, bf16x8 pa2, bf16x8 pa3) {
  pv_one<0>(o[0], vb, pa0, pa1, pa2, pa3); pv_one<1>(o[1], vb, pa0, pa1, pa2, pa3); pv_one<2>(o[2], vb, pa0, pa1, pa2, pa3); pv_one<3>(o[3], vb, pa0, pa1, pa2, pa3);
}

__device__ __forceinline__ void attn_unit(const unsigned short* __restrict__ Qb, const unsigned short* __restrict__ Kh, const unsigned short* __restrict__ Vh,
                                          unsigned short* __restrict__ Ob, float* __restrict__ rss, char* lds) {
  int tid_ = threadIdx.x; asm volatile("" : "+v"(tid_));
  const int tid = tid_, wid = tid >> 6, lane = tid & 63, r32 = lane & 31, hi = lane >> 5;
  unsigned short* V_lds = (unsigned short*)lds; unsigned short* K_lds = (unsigned short*)(lds + 2 * SHM_V);
  float* ws = (float*)(lds + 2 * SHM_V + 2 * SHM_K) + wid * 64; float* li_l = ws; float* al_l = ws + 32;
  float m_reg = -1e30f, l_reg = 0; f32x16 o[4] = {}; bf16x8 qr[8];
  const unsigned short* Qw = Qb + (long)(wid * QBLK + r32) * LDQ + hi * 8;
#pragma unroll
  for (int d0 = 0; d0 < 8; ++d0) qr[d0] = *reinterpret_cast<const bf16x8*>(Qw + d0 * 16);
  const int sr = tid >> 4, sc = (tid & 15) * 8, vst0 = v_st(sr, sc), vst1 = v_st(32 + sr, sc);
  const int vb0 = (int)(uintptr_t)V_lds + v_rd_base(lane);
  struct { bf16x8 vs0, vs1, ks0, ks1; } sr_[2];
#define SLOAD(i, k0) do { sr_[i].vs0 = *reinterpret_cast<const bf16x8*>(&Vh[(long)((k0) + sr) * LDK + sc]); sr_[i].vs1 = *reinterpret_cast<const bf16x8*>(&Vh[(long)((k0) + 32 + sr) * LDK + sc]); \
    sr_[i].ks0 = *reinterpret_cast<const bf16x8*>(&Kh[(long)((k0) + sr) * LDK + sc]); sr_[i].ks1 = *reinterpret_cast<const bf16x8*>(&Kh[(long)((k0) + 32 + sr) * LDK + sc]); } while (0)
#define SWRITE(b, i) do { *(bf16x8*)((char*)V_lds + (b) * SHM_V + vst0) = sr_[i].vs0;          \
    *(bf16x8*)((char*)V_lds + (b) * SHM_V + vst1) = sr_[i].vs1; int kc = sc * 2;               \
    *(bf16x8*)((char*)K_lds + (b) * SHM_K + KSWZ(sr, kc)) = sr_[i].ks0;                       \
    *(bf16x8*)((char*)K_lds + (b) * SHM_K + KSWZ(32 + sr, kc)) = sr_[i].ks1; } while (0)
#define SWAIT() asm volatile("s_waitcnt vmcnt(4)" ::: "memory")
#define RESC(a) do { if (__any((a) < 1.f)) { if (hi == 0) al_l[r32] = (a); asm volatile("s_waitcnt lgkmcnt(0)" ::: "memory"); \
    for (int d = 0; d < 4; ++d) for (int r = 0; r < 16; ++r) o[d][r] *= al_l[crow(r, hi)]; } } while (0)
  f32x16 pA0, pA1, pB0, pB1; float mnA, mnB, alA, alB; bf16x8 pa0, pa1, pa2, pa3;
  constexpr int SE = 0, SO = 1;
  SLOAD(SE, 0); asm volatile("s_waitcnt vmcnt(0)" ::: "memory"); SWRITE(0, SE); __syncthreads();
  qkt(pA0, pA1, K_lds, qr, r32, hi);
#ifndef ATT_NOMASK
#pragma unroll
  for (int r = 8; r < 16; ++r) pA0[r] = -1e30f;
#pragma unroll
  for (int r = 0; r < 16; ++r) pA1[r] = -1e30f;
#endif
  partialSM(pA0, pA1, m_reg, mnA, alA);
  SLOAD(SO, KVBLK); SLOAD(SE, 2 * KVBLK);
  SWAIT(); SWRITE(1, SO); __syncthreads();
  for (int j = 1; j + 1 < NT; j += 2) {
    SBAR(); qkt(pB0, pB1, (unsigned short*)((char*)K_lds + SHM_K), qr, r32, hi);
    finishSM(pA0, pA1, alA, l_reg, pa0, pa1, pa2, pa3); SBAR();
    SLOAD(SO, (j + 2) * KVBLK); SBAR();
    pv_d0(o, vb0, pa0, pa1, pa2, pa3); partialSM(pB0, pB1, m_reg, mnB, alB);
    __syncthreads(); SWAIT(); SWRITE(0, SE);
    RESC(alB); __syncthreads();
    SBAR(); qkt(pA0, pA1, K_lds, qr, r32, hi);
    finishSM(pB0, pB1, alB, l_reg, pa0, pa1, pa2, pa3); SBAR();
    if (j + 3 < NT) SLOAD(SE, (j + 3) * KVBLK); SBAR();
    pv_d0(o, vb0 + (int)SHM_V, pa0, pa1, pa2, pa3); partialSM(pA0, pA1, m_reg, mnA, alA);
    __syncthreads(); SWAIT(); SWRITE(1, SO);
    RESC(alA); __syncthreads();
  }
  finishSM(pA0, pA1, alA, l_reg, pa0, pa1, pa2, pa3); SBAR();
  pv_d0(o, vb0, pa0, pa1, pa2, pa3);
  if (hi == 0) li_l[r32] = l_reg; asm volatile("s_waitcnt lgkmcnt(0)" ::: "memory");
  float rli[16];
#pragma unroll
  for (int r = 0; r < 16; ++r) rli[r] = __builtin_amdgcn_rcpf(li_l[crow(r, hi)]);
#ifdef ATT_NOSS
  unsigned short* Ow = Ob + (long)(wid * QBLK) * DM;
#pragma unroll
  for (int r = 0; r < 16; ++r) { const int orow = crow(r, hi);
    for (int d0 = 0; d0 < 4; ++d0) { const float v = o[d0][r] * rli[r]; const unsigned u = __float_as_uint(v); Ow[(long)orow * DM + d0 * 32 + r32] = (unsigned short)((u + 0x7fffu + ((u >> 16) & 1u)) >> 16); } }
#else
  unsigned short* Ow = Ob + (long)(wid * QBLK) * DM;
#pragma unroll
  for (int r = 0; r < 16; ++r) { const int orow = crow(r, hi); float ss = 0.f;
#pragma unroll
    for (int d0 = 0; d0 < 4; ++d0) { const float v = o[d0][r] * rli[r]; ss += v * v;
      const unsigned u = __float_as_uint(v); Ow[(long)orow * DM + d0 * 32 + r32] = (unsigned short)((u + 0x7fffu + ((u >> 16) & 1u)) >> 16); }
    ss += __shfl_xor(ss, 1); ss += __shfl_xor(ss, 2); ss += __shfl_xor(ss, 4); ss += __shfl_xor(ss, 8); ss += __shfl_xor(ss, 16);
    if (r32 == 0) unsafeAtomicAdd(rss + wid * QBLK + orow, ss); }
#endif
  __syncthreads();
#undef SLOAD
#undef SWRITE
#undef SWAIT
#undef RESC
}
#undef KSWZ
#undef SBAR
}
namespace tg {
#define TG_LAS __attribute__((address_space(3)))
typedef _Float16 f16x8 __attribute__((ext_vector_type(8)));
typedef _Float16 f16x4 __attribute__((ext_vector_type(4)));
typedef short s16x4 __attribute__((ext_vector_type(4)));
typedef float f32x4 __attribute__((ext_vector_type(4)));
typedef unsigned u32x4 __attribute__((ext_vector_type(4)));
constexpr int APITCH = 80, BN = 128, BPITCH = BN * 2 + 32;
template <int MT> struct Cfg { static constexpr int BM = 32 * MT, ABYTES = BM * APITCH, BBYTES = 32 * BPITCH, NPA = (BM * 4 + 511) / 512, LDS_BYTES = 2 * (ABYTES + BBYTES); };

template <int MT, class Epi>
__device__ __forceinline__ void unit(TG_LAS unsigned char* lds, const _Float16* __restrict__ A, int lda, const _Float16* __restrict__ Bp, long ldb, int kvalid, int ksteps, const Epi& E) {
    typedef Cfg<MT> C;
    const int tid = threadIdx.x, lane = tid & 63, wid = __builtin_amdgcn_readfirstlane(tid >> 6), wm = wid >> 2, wn = wid & 3;
    f32x4 acc[MT][2];
#pragma unroll
    for (int m = 0; m < MT; ++m) { acc[m][0] = (f32x4){0.f, 0.f, 0.f, 0.f}; acc[m][1] = (f32x4){0.f, 0.f, 0.f, 0.f}; }
    u32x4 ra[C::NPA], rb;
    const int brow = tid >> 4, bch = tid & 15;
#define TG_LOAD(kt) do { _Pragma("unroll") for (int p = 0; p < C::NPA; ++p) { const int idx = tid + 512 * p; \
            if (idx < C::BM * 4) ra[p] = *(const u32x4*)(A + (size_t)(idx >> 2) * lda + (kt) * 32 + (idx & 3) * 8); } \
        { const int k = (kt) * 32 + brow; rb = (u32x4){0u, 0u, 0u, 0u}; if (k < kvalid) rb = *(const u32x4*)(Bp + (size_t)k * ldb + bch * 8); } } while (0)
#define TG_STORE(buf) do { _Pragma("unroll") for (int p = 0; p < C::NPA; ++p) { const int idx = tid + 512 * p; \
            if (idx < C::BM * 4) *(TG_LAS u32x4*)(lds + (buf) * C::ABYTES + (idx >> 2) * APITCH + (idx & 3) * 16) = ra[p]; } \
        *(TG_LAS u32x4*)(lds + 2 * C::ABYTES + (buf) * C::BBYTES + brow * BPITCH + bch * 16) = rb; } while (0)
    const int aoff = (wm * 16 * MT + (lane & 15)) * APITCH + (lane >> 4) * 16;
    const int boff = (8 * (lane >> 4) + ((lane >> 2) & 3)) * BPITCH + (wn * 32 + 4 * (lane & 3)) * 2;
    TG_LOAD(0); TG_STORE(0); __syncthreads();
    for (int kt = 0; kt < ksteps; ++kt) {
        const int buf = kt & 1;
        if (kt + 1 < ksteps) TG_LOAD(kt + 1);
        f16x8 af[MT], bfr[2];
#pragma unroll
        for (int m = 0; m < MT; ++m) af[m] = *(const TG_LAS f16x8*)(lds + buf * C::ABYTES + aoff + m * 16 * APITCH);
#pragma unroll
        for (int n = 0; n < 2; ++n) { const TG_LAS unsigned char* bp = lds + 2 * C::ABYTES + buf * C::BBYTES + boff + n * 32;
            const s16x4 lo = __builtin_amdgcn_ds_read_tr16_b64_v4i16((TG_LAS s16x4*)bp), hi = __builtin_amdgcn_ds_read_tr16_b64_v4i16((TG_LAS s16x4*)(bp + 4 * BPITCH));
            const f16x4 l4 = __builtin_bit_cast(f16x4, lo), h4 = __builtin_bit_cast(f16x4, hi);
            bfr[n] = (f16x8){l4[0], l4[1], l4[2], l4[3], h4[0], h4[1], h4[2], h4[3]}; }
#pragma unroll
        for (int m = 0; m < MT; ++m)
#pragma unroll
            for (int n = 0; n < 2; ++n) acc[m][n] = __builtin_amdgcn_mfma_f32_16x16x32_f16(af[m], bfr[n], acc[m][n], 0, 0, 0);
        if (kt + 1 < ksteps) TG_STORE(buf ^ 1);
        __syncthreads();
    }
    E(acc, wm, wn, lane);
#undef TG_LOAD
#undef TG_STORE
}

struct EpiS1 {
    const float2* TW; _Float16* T1; int b, l2, c0;
    __device__ __forceinline__ void operator()(const f32x4 (&acc)[5][2], int wm, int wn, int lane) const {
        const int g = lane >> 4, cl = lane & 15;
#pragma unroll
        for (int m = 0; m < 5; ++m) { const int k1a = wm * 40 + 8 * m + 2 * g;
            const float2 t0 = TW[k1a * FN2 + l2], t1 = TW[(k1a + 1) * FN2 + l2];
#pragma unroll
            for (int n = 0; n < 2; ++n) { const int col = c0 + wn * 32 + 16 * n + cl; const f32x4 a = acc[m][n];
                _Float16* p0 = T1 + ((((size_t)b * FN1 + k1a) * FN2 + l2) * 2) * 512 + col; _Float16* p1 = p0 + (size_t)FN2 * 2 * 512;
                p0[0] = (_Float16)(a[0] * t0.x + a[1] * t0.y); p0[512] = (_Float16)(a[1] * t0.x - a[0] * t0.y);
                p1[0] = (_Float16)(a[2] * t1.x + a[3] * t1.y); p1[512] = (_Float16)(a[3] * t1.x - a[2] * t1.y); } }
    }
};
struct EpiS2 {
    _Float16* AB; int b, k1, q4;
    __device__ __forceinline__ void operator()(const f32x4 (&acc)[13][2], int wm, int wn, int lane) const {
        const int g = lane >> 4, cl = lane & 15;
#pragma unroll
        for (int m = 0; m < 13; ++m) { const int k2a = wm * 104 + 8 * m + 2 * g;
#pragma unroll
            for (int rr = 0; rr < 2; ++rr) { const int k2 = k2a + rr;
                if (k2 < FN2) { const int tok = k1 + FN1 * k2; _Float16* p = AB + ((((size_t)b * LTOK + tok) * 4 + q4) * 2) * 128 + wn * 32 + cl;
#pragma unroll
                    for (int n = 0; n < 2; ++n) { p[16 * n] = (_Float16)(acc[m][n][2 * rr] * (1.0f / 128.0f)); p[128 + 16 * n] = (_Float16)(acc[m][n][2 * rr + 1] * (1.0f / 128.0f)); } } } }
    }
};
struct EpiCM {
    unsigned short* MIX; float* rssf; int row0, g;
    __device__ __forceinline__ void operator()(const f32x4 (&acc)[4][2], int wm, int wn, int lane) const {
        const int gq = lane >> 4, cl = lane & 15;
#pragma unroll
        for (int m = 0; m < 4; ++m)
#pragma unroll
            for (int r = 0; r < 4; ++r) { const int row = row0 + wm * 64 + 16 * m + 4 * gq + r; float ss = 0.f;
                unsigned short* p = MIX + (size_t)row * DM + 512 + g * 128 + wn * 32 + cl;
#pragma unroll
                for (int n = 0; n < 2; ++n) { const float v = acc[m][n][r]; ss += v * v; const unsigned u = __float_as_uint(v); p[16 * n] = (unsigned short)((u + 0x7fffu + ((u >> 16) & 1u)) >> 16); }
                ss += __shfl_xor(ss, 1); ss += __shfl_xor(ss, 2); ss += __shfl_xor(ss, 4); ss += __shfl_xor(ss, 8);
                if (cl == 0) unsafeAtomicAdd(rssf + row, ss); }
    }
};
}
constexpr int NWAVES = 8;
#ifndef MK_N_LAUNCHES
#define MK_N_LAUNCHES 1
#endif
constexpr int N_PHASES = 9;
constexpr int N_LAUNCHES = MK_N_LAUNCHES;

constexpr size_t MiB = 1u << 20;
constexpr size_t WS_CTL = 0, CTL_ZERO_BYTES = 2 * MiB;
constexpr size_t WS_RSSA = 1 * MiB, WS_RSSF = WS_RSSA + 128 * 1024, WS_RSSM = WS_RSSF + 128 * 1024, WS_RSS2 = WS_RSSM + 128 * 1024;
constexpr size_t WS_WIN = 2 * MiB, WS_WOUT = 5 * MiB, WS_WUP = 7 * MiB, WS_WDN = 15 * MiB;
constexpr size_t WS_TAB = 23 * MiB;
constexpr size_t WS_ROPE = WS_TAB, WS_W1 = WS_TAB + 128 * 1024, WS_W2 = WS_TAB + 192 * 1024, WS_TW = WS_TAB + 576 * 1024, WS_MG = WS_TAB + 768 * 1024;
constexpr size_t WS_HID = 24 * MiB;
constexpr size_t WS_MIX = WS_HID, WS_Q = WS_HID + 64 * MiB, WS_K = WS_HID + 96 * MiB, WS_V = WS_HID + 113 * MiB, WS_U = WS_HID + 130 * MiB, WS_T1 = WS_HID + 163 * MiB;
constexpr size_t WS_H1 = 280 * MiB;
constexpr size_t WS_XN = WS_H1, WS_AB = WS_H1, WS_QKRAW = WS_H1 + 65 * MiB;
constexpr size_t WS_H1B = 408 * MiB, WS_END = 472 * MiB;
static_assert((size_t)MPAD * DM * 2 <= 65 * MiB && WS_QKRAW + (size_t)MPAD * 768 * 4 <= WS_END && (size_t)BATCH * LTOK * 1024 * 2 <= 65 * MiB, "ws map (H1 region)");
static_assert((size_t)BATCH * HKV * LPA * 128 * 2 <= 17 * MiB && (size_t)BATCH * LTOK * 512 * 2 <= 33 * MiB && WS_T1 + (size_t)BATCH * LTOK * 2 * 512 * 2 <= WS_HID + 256 * MiB, "ws map (HID region)");
constexpr int CW_BAR = 4096;

constexpr int RING_OFF = 0, RING_BYTES = 131072;
constexpr int LDSCTL_OFF = RING_BYTES, MISC_OFF = LDSCTL_OFF + 320;
constexpr int LDS_BYTES = 147456;
static_assert(att::SHM_ATTN <= RING_BYTES && tg::Cfg<13>::LDS_BYTES <= RING_BYTES, "LDS map");

#define GAS __attribute__((address_space(1)))
#define LAS __attribute__((address_space(3)))
typedef unsigned short bf16;
typedef unsigned v4u __attribute__((ext_vector_type(4)));
typedef float f32x4 __attribute__((ext_vector_type(4)));
typedef GAS unsigned gu32;
#define RLX_AGENT __ATOMIC_RELAXED, __HIP_MEMORY_SCOPE_AGENT
#define LDS_WAIT() asm volatile("s_waitcnt lgkmcnt(0)" ::: "memory")
#define VM_WAIT() asm volatile("s_waitcnt vmcnt(0)" ::: "memory")
__device__ __forceinline__ unsigned f2bf(float f) { unsigned u = __builtin_bit_cast(unsigned, f); return (u + 0x7fffu + ((u >> 16) & 1u)) >> 16; }
__device__ __forceinline__ unsigned pk2(float lo, float hi) { return f2bf(lo) | (f2bf(hi) << 16); }

#define XB_TMO      128
#define XB_XCNT(j)  (256  + 64 * (j))
#define XB_XSUB(j)  (1280 + 64 * (j))
#define XB_XGEN(j)  (2304 + 64 * (j))
#define XB_TOP      3328
#define XB_TOPGEN   3392
#define XCD_BAR_WORDS 3456
#define XB_SPIN_CAP (1u << 18)

__device__ __forceinline__ unsigned xb_ld(unsigned* p)              { return __hip_atomic_load(p, __ATOMIC_RELAXED, __HIP_MEMORY_SCOPE_AGENT); }
__device__ __forceinline__ unsigned xb_add(unsigned* p, unsigned v) { return __hip_atomic_fetch_add(p, v, __ATOMIC_RELAXED, __HIP_MEMORY_SCOPE_AGENT); }
__device__ __forceinline__ unsigned xb_xcc_id() { return (unsigned)__builtin_amdgcn_s_getreg((3 << 11) | 20) & 0xFu; }
#define XB_SPIN(cond, bar) do { unsigned _sp = 0; while (cond) { __builtin_amdgcn_s_sleep(1); \
    if ((++_sp & 255u) == 0u) { if (xb_ld(&(bar)[XB_TMO])) break; if (_sp > XB_SPIN_CAP) { atomicAdd(&(bar)[XB_TMO], 1u); break; } } } } while (0)

struct XcdBarrier {
    unsigned* bar; unsigned x;
    volatile LAS unsigned* st;
};

__device__ __forceinline__ XcdBarrier xcd_barrier_post(unsigned* bar, volatile LAS unsigned* st) {
    XcdBarrier b; b.bar = bar; b.x = xb_xcc_id(); b.st = st;
    if (threadIdx.x == 0) (void)xb_add(&bar[XB_XCNT(b.x)], 1u);
    return b;
}
__device__ __forceinline__ void xcd_barrier_complete(unsigned* bar, unsigned x, unsigned& nloc, unsigned& nx) {
    const unsigned G = gridDim.x * gridDim.y * gridDim.z;
    unsigned sum, cnt, mine, sp = 0u;
    for (;;) {
        sum = 0u; cnt = 0u; mine = 0u;
#pragma unroll
        for (unsigned j = 0; j < 16; ++j) { const unsigned c = xb_ld(&bar[XB_XCNT(j)]); sum += c; cnt += (c > 0u) ? 1u : 0u; mine = (j == x) ? c : mine; }
        if (sum == G) break;
        __builtin_amdgcn_s_sleep(1);
        if ((++sp & 255u) == 0u) { if (xb_ld(&bar[XB_TMO])) break; if (sp > XB_SPIN_CAP) { atomicAdd(&bar[XB_TMO], 1u); break; } }
    }
    nloc = mine > 0u ? mine : 1u; nx = cnt > 0u ? cnt : 1u;
}

__device__ __forceinline__ void xcd_barrier(const XcdBarrier& b) {
    asm volatile("s_waitcnt vmcnt(0)" ::: "memory");
    __syncthreads();
    if (threadIdx.x == 0) {
        unsigned* bar = b.bar;
        __builtin_amdgcn_s_waitcnt(0);
        unsigned nloc = b.st[0], nx = b.st[1];
        if (nloc == 0u) { xcd_barrier_complete(bar, b.x, nloc, nx); b.st[0] = nloc; b.st[1] = nx; }
        const unsigned old = xb_add(&bar[XB_XSUB(b.x)], 1u);
        const unsigned gen = old / nloc;
        if (old + 1u == (gen + 1u) * nloc) {
            __builtin_amdgcn_fence(__ATOMIC_RELEASE, "agent");
            asm volatile("s_waitcnt vmcnt(0)" ::: "memory");
            const unsigned og = xb_add(&bar[XB_TOP], 1u);
            const unsigned tg = og / nx;
            if (og + 1u == (tg + 1u) * nx) xb_add(&bar[XB_TOPGEN], 1u);
            else XB_SPIN(xb_ld(&bar[XB_TOPGEN]) == tg, bar);
            __builtin_amdgcn_fence(__ATOMIC_ACQUIRE, "agent");
            xb_add(&bar[XB_XGEN(b.x)], 1u);
            asm volatile("s_waitcnt vmcnt(0)" ::: "memory");
        } else {
            XB_SPIN(xb_ld(&bar[XB_XGEN(b.x)]) == gen, bar);
            __builtin_amdgcn_fence(__ATOMIC_ACQUIRE, "agent");
            asm volatile("s_waitcnt vmcnt(0)" ::: "memory");
        }
    }
    __syncthreads();
}

struct Frame {
    LAS unsigned char* lds;
    volatile LAS unsigned* MISC;
    gu32* ctl;
    int tid, lane, wave;
    int vcu, G;
};

__device__ __forceinline__ float wave_sum(float v) {
#pragma unroll
    for (int o = 1; o < 64; o <<= 1) v += __shfl_xor(v, o);
    return v;
}
__device__ __forceinline__ void p0_transpose_item(const float* W, int K, int N, bf16* WT, const float* gk, LAS float* scr, int item, int lane) {
    const int nblk = N / 32, kb = item / nblk, nb = item % nblk, k0 = 64 * kb, n0 = 32 * nb;
#pragma unroll 8
    for (int i = 0; i < 32; ++i) { const int kk = 2 * i + (lane >> 5); scr[kk * 33 + (lane & 31)] = W[(size_t)(k0 + kk) * N + n0 + (lane & 31)]; }
    LDS_WAIT(); asm volatile("" ::: "memory");
    const int c = lane & 7;
    float gg[8];
#pragma unroll
    for (int e = 0; e < 8; ++e) gg[e] = gk ? gk[k0 + 8 * c + e] : 1.0f;
#pragma unroll
    for (int j = 0; j < 4; ++j) { const int n = (lane >> 3) + 8 * j; const LAS float* s = scr + (8 * c) * 33 + n;
        v4u o; o.x = pk2(s[0 * 33] * gg[0], s[1 * 33] * gg[1]); o.y = pk2(s[2 * 33] * gg[2], s[3 * 33] * gg[3]); o.z = pk2(s[4 * 33] * gg[4], s[5 * 33] * gg[5]); o.w = pk2(s[6 * 33] * gg[6], s[7 * 33] * gg[7]);
        *(GAS v4u*)(WT + (size_t)(n0 + n) * K + k0 + 8 * c) = o; }
    LDS_WAIT(); asm volatile("" ::: "memory");
}
__device__ __forceinline__ void rms_row_to_bf16(int lane, const float* xrow, const float* g, bf16* orow) {
    const GAS f32x4* xr = (const GAS f32x4*)xrow + lane; const GAS f32x4* gr = (const GAS f32x4*)g + lane;
    f32x4 v[4]; float s2 = 0.f;
#pragma unroll
    for (int j = 0; j < 4; ++j) { v[j] = xr[64 * j]; s2 += (v[j].x * v[j].x + v[j].y * v[j].y) + (v[j].z * v[j].z + v[j].w * v[j].w); }
    const float rstd = 1.f / sqrtf(wave_sum(s2) * (1.f / DM) + RMS_EPS);
    GAS unsigned long long* o8 = (GAS unsigned long long*)orow + lane;
#pragma unroll
    for (int j = 0; j < 4; ++j) { const f32x4 gv = gr[64 * j]; o8[64 * j] = (unsigned long long)pk2(v[j].x * rstd * gv.x, v[j].y * rstd * gv.y) | ((unsigned long long)pk2(v[j].z * rstd * gv.z, v[j].w * rstd * gv.w) << 32); }
}
__device__ __forceinline__ void cs2pi(int num, int den, float& c, float& s) {
    const float x = (float)(2 * num) / (float)den; c = cospif(x); s = sinpif(x);
}

struct Args { const float* in[14]; float* out; unsigned char* ws; int ph_lo, ph_hi, li, pad; };

__global__ void __launch_bounds__(NWAVES * 64, 2) hymba_fwd(Args args) {
    extern __shared__ __attribute__((aligned(16))) unsigned char lds[];
    Frame F;
    F.lds = (LAS unsigned char*)lds;
    F.MISC = (volatile LAS unsigned*)(F.lds + MISC_OFF);
    F.tid = threadIdx.x; F.lane = F.tid & 63; F.wave = __builtin_amdgcn_readfirstlane(F.tid >> 6);
    F.G = gridDim.x; { const int bx = blockIdx.x; F.vcu = (F.G % 8 == 0) ? (bx % 8) * (F.G / 8) + bx / 8 : bx; }
    unsigned char* ws = args.ws;
    F.ctl = (gu32*)(ws + WS_CTL);
    const float* x = args.in[0]; const float* meta_tokens = args.in[1]; const float* g_mix = args.in[2]; const float* w_in = args.in[3]; const float* g_q = args.in[4]; const float* g_k = args.in[5];
    const float* w_fourier = args.in[6]; const float* g_attn_out = args.in[7]; const float* g_fourier_out = args.in[8]; const float* w_out = args.in[9]; const float* g_mlp = args.in[10];
    const float* w_up = args.in[11]; const float* w_down = args.in[12]; const float* g_final = args.in[13]; float* out = args.out;
    bf16* WIN_T = (bf16*)(ws + WS_WIN); bf16* WOUT_T = (bf16*)(ws + WS_WOUT); bf16* WUP_T = (bf16*)(ws + WS_WUP); bf16* WDN_T = (bf16*)(ws + WS_WDN);
    float2* ROPE = (float2*)(ws + WS_ROPE); _Float16* W1 = (_Float16*)(ws + WS_W1); _Float16* W2 = (_Float16*)(ws + WS_W2); float2* TW = (float2*)(ws + WS_TW); _Float16* MG = (_Float16*)(ws + WS_MG);
    bf16* MIX = (bf16*)(ws + WS_MIX); bf16* QB = (bf16*)(ws + WS_Q); bf16* KB = (bf16*)(ws + WS_K); bf16* VB = (bf16*)(ws + WS_V); _Float16* UB = (_Float16*)(ws + WS_U); _Float16* T1 = (_Float16*)(ws + WS_T1);
    bf16* XN = (bf16*)(ws + WS_XN); _Float16* AB = (_Float16*)(ws + WS_AB); float* QKRAW = (float*)(ws + WS_QKRAW);
    float* H1 = (float*)(ws + WS_H1); bf16* H1B = (bf16*)(ws + WS_H1B); bf16* HID = (bf16*)(ws + WS_HID);
    float* RSSA = (float*)(ws + WS_RSSA); float* RSSF = (float*)(ws + WS_RSSF); float* RSSM = (float*)(ws + WS_RSSM); float* RSS2 = (float*)(ws + WS_RSS2);

    for (int u = F.tid; u < (LDS_BYTES - LDSCTL_OFF) / 4; u += NWAVES * 64) ((LAS unsigned*)(F.lds + LDSCTL_OFF))[u] = 0u;
    __syncthreads();
    XcdBarrier bar = xcd_barrier_post((unsigned*)(F.ctl + CW_BAR) + args.li * XCD_BAR_WORDS, F.MISC + 8);
#define GRID_BAR() xcd_barrier(bar)
    const int lo = args.ph_lo, hi = args.ph_hi;
#ifndef ONLY_PHASE
#define ONLY_PHASE -1
#endif
#define IN(k) ((ONLY_PHASE < 0 || ONLY_PHASE == (k)) && lo <= (k) && (k) < hi)
#define BOTH(k) (IN(k) && IN((k) + 1))
    const int gw = F.vcu * NWAVES + F.wave, NGW = F.G * NWAVES;
    const int gt = blockIdx.x * (NWAVES * 64) + F.tid, NGT = F.G * NWAVES * 64;

    if (IN(0)) {
        LAS float* scr = (LAS float*)(F.lds + RING_OFF + F.wave * 16384);
        typedef float f32x2l __attribute__((ext_vector_type(2)));
        LAS f32x2l* cs128 = (LAS f32x2l*)(F.lds + RING_OFF + 8 * 16384 - 1024);
        if (F.tid < 128) { float c, s; cs2pi(F.tid, 128, c, s); cs128[F.tid] = (f32x2l){c, s}; }
        __syncthreads();
        constexpr int I_IN = (DM / 64) * (NPROJ / 32), I_OUT = (DM / 64) * (DM / 32), I_UP = (DM / 64) * (DFF / 32), I_DN = (DFF / 64) * (DM / 32);
        constexpr int NITEMS = I_IN + I_OUT + I_UP + I_DN;
        for (int it = gw; it < NITEMS; it += NGW) {
            int r = it;
            if (r < I_IN) { p0_transpose_item(w_in, DM, NPROJ, WIN_T, nullptr, scr, r, F.lane); continue; } r -= I_IN;
            if (r < I_OUT) { const int kb = r / (DM / 32); p0_transpose_item(w_out, DM, DM, WOUT_T, (kb < 8) ? g_attn_out - 0 : g_fourier_out - 512, scr, r, F.lane); continue; } r -= I_OUT;
            if (r < I_UP) { p0_transpose_item(w_up, DM, DFF, WUP_T, g_mlp, scr, r, F.lane); continue; } r -= I_UP;
            p0_transpose_item(w_down, DFF, DM, WDN_T, nullptr, scr, r, F.lane);
        }
        for (int m = gw; m < MPAD; m += NGW) {
            if (m < MR) rms_row_to_bf16(F.lane, x + (size_t)m * DM, g_mix, XN + (size_t)m * DM);
            else if (m < MR + NMETA) rms_row_to_bf16(F.lane, meta_tokens + (size_t)(m - MR) * DM, g_mix, XN + (size_t)m * DM);
            else { GAS unsigned long long* o8 = (GAS unsigned long long*)(XN + (size_t)m * DM) + F.lane;
#pragma unroll
                for (int j = 0; j < 4; ++j) o8[64 * j] = 0ull; }
        }
        for (int i = gt; i < 257 * 32; i += NGT) { const int p = i >> 5, j = i & 31; const float invf = exp2f(-(float)j * (13.287712379549449f / 32.0f)); const float ang = (float)(p - 1) * invf;
            double rv = (double)ang * 0.15915494309189535; rv -= rint(rv); const float xr = (float)(2.0 * rv); ROPE[i] = make_float2(cospif(xr), sinpif(xr)); }
        for (int i = gt; i < 160 * 96; i += NGT) { const int m = i / 96, l1 = i % 96, k1 = m >> 1; float v = 0.f;
            if (l1 < FN1) { float c, s; cs2pi((k1 * l1) % FN1, FN1, c, s); v = (m & 1) ? -s : c; } W1[i] = (_Float16)v; }
        for (int i = gt; i < 416 * 416; i += NGT) { const int m = i / 416, kk = i % 416, k2 = m >> 1, l2 = kk >> 1; float v = 0.f;
            if (k2 < FN2 && l2 < FN2) { float c, s; cs2pi((k2 * l2) % FN2, FN2, c, s); v = (m & 1) ? ((kk & 1) ? -c : s) : ((kk & 1) ? s : c); } W2[i] = (_Float16)v; }
        for (int i = gt; i < FN1 * FN2; i += NGT) { const int k1 = i / FN2, l2 = i % FN2; float c, s; cs2pi(k1 * l2, LTOK, c, s); TW[i] = make_float2(c, s); }
        for (int i = gt; i < 4 * 256 * 128; i += NGT) { const int d = i & 127, kk = (i >> 7) & 255, g = i >> 15, c = kk & 127; const bool isB = kk >= 128; float a = 0.f;
            const float* wf = w_fourier + (size_t)g * 128 * 128 + d;
            for (int m = 0; m < 128; ++m) { const f32x2l t = cs128[(m * c) & 127]; a += (isB ? -t.y : t.x) * wf[m * 128]; }
            MG[i] = (_Float16)(a * 0.088345190f); }
        for (int i = gt; i < 4 * 112 * 16; i += NGT) { const int ch = i & 15, rr = (i >> 4) % 112, img = (i >> 4) / 112; const int row = rr < 48 ? 16 + rr : 16448 + (rr - 48);
            const size_t off = ((size_t)img * LPA + row) * 128 + ch * 8; *(v4u*)(KB + off) = (v4u){0u, 0u, 0u, 0u}; *(v4u*)(VB + off) = (v4u){0u, 0u, 0u, 0u}; }
        if (BOTH(0)) GRID_BAR();
    }

    if (IN(1)) {
        pg8::Gemm g{XN, WIN_T, MPAD, NPROJ, DM}; pg8::InProjOrder S; S.init(F.G, (int)blockIdx.x);
        pg8::EpiInProj E{QKRAW, VB, UB};
        pg8::gemm_phase<pg8::EpiInProj, pg8::InProjOrder, true, true>(F.lds + RING_OFF, g, S, E);
        if (BOTH(1)) GRID_BAR();
    }

    if (IN(2)) {
        for (int R = gw; R < MR + NMETA; R += NGW) {
            const bool meta = R >= MR; const int b = R >> 14, t = R & (SEQ - 1), jm = R - MR, j = F.lane & 31;
            const int prow = meta ? 0 : (t >> 6) + 1, pcol = meta ? jm + 1 : (t & 63) + 1;
            const float2 cr = ROPE[prow * 32 + j], cc = ROPE[pcol * 32 + j];
            for (int p = meta ? 2 : 0; p < 3; ++p) {
                const int hh = 2 * p + (F.lane >> 5); const float* src = QKRAW + (size_t)R * 768 + hh * 128 + j; const float* gg = (hh < 4 ? g_q : g_k) + j;
                float y0 = src[0], y1 = src[32], y2 = src[64], y3 = src[96];
                float ss = (y0 * y0 + y1 * y1) + (y2 * y2 + y3 * y3);
                ss += __shfl_xor(ss, 1); ss += __shfl_xor(ss, 2); ss += __shfl_xor(ss, 4); ss += __shfl_xor(ss, 8); ss += __shfl_xor(ss, 16);
                const float rstd = 1.f / sqrtf(ss * (1.f / 128.f) + RMS_EPS);
                y0 *= rstd * gg[0]; y1 *= rstd * gg[32]; y2 *= rstd * gg[64]; y3 *= rstd * gg[96];
                const unsigned o0 = f2bf(y0 * cr.x - y1 * cr.y), o1 = f2bf(y1 * cr.x + y0 * cr.y), o2 = f2bf(y2 * cc.x - y3 * cc.y), o3 = f2bf(y3 * cc.x + y2 * cc.y);
                if (hh < 4) { bf16* q = QB + ((size_t)(b * HQ + hh) * SEQ + t) * 128 + j; q[0] = (bf16)o0; q[32] = (bf16)o1; q[64] = (bf16)o2; q[96] = (bf16)o3; }
                else if (!meta) { bf16* k = KB + ((size_t)(b * HKV + hh - 4) * LPA + 64 + t) * 128 + j; k[0] = (bf16)o0; k[32] = (bf16)o1; k[64] = (bf16)o2; k[96] = (bf16)o3; }
                else {
#pragma unroll
                    for (int bb = 0; bb < 2; ++bb) { bf16* k = KB + ((size_t)(bb * HKV + hh - 4) * LPA + jm) * 128 + j; k[0] = (bf16)o0; k[32] = (bf16)o1; k[64] = (bf16)o2; k[96] = (bf16)o3; } }
            }
        }
        for (int ui = F.vcu; ui < BATCH * FN2 * 4; ui += F.G) { const int b = ui / (FN2 * 4), nt_ = ui % (FN2 * 4), l2 = nt_ >> 2, c0 = (nt_ & 3) * 128;
            tg::EpiS1 E{TW, T1, b, l2, c0};
            tg::unit<5, tg::EpiS1>(F.lds + RING_OFF, W1, 96, UB + ((size_t)b * LTOK + l2) * 512 + c0, (long)FN2 * 512, FN1, 3, E); }
        if (BOTH(2)) GRID_BAR();
    }

    if (IN(3)) {
#ifndef NO_S2
        for (int ui = F.vcu; ui < BATCH * FN1 * 4; ui += F.G) { const int b = ui / (FN1 * 4), r = ui % (FN1 * 4), k1 = r >> 2, q4 = r & 3;
            tg::EpiS2 E{AB, b, k1, q4};
            tg::unit<13, tg::EpiS2>(F.lds + RING_OFF, W2, 416, T1 + ((size_t)(b * FN1 + k1) * (2 * FN2)) * 512 + q4 * 128, 512, 2 * FN2, 13, E); }
#endif
#ifndef NO_ATT
        for (int i = 0; i < 2; ++i) { const int un = F.vcu * 2 + i; if (un >= BATCH * HQ * (SEQ / 256)) break;
            const int bh = un >> 6, qb = un & 63, b = bh >> 2, h = bh & 3, kvh = h >> 1;
            att::attn_unit(QB + ((size_t)bh * SEQ + qb * 256) * 128, KB + (size_t)(b * HKV + kvh) * LPA * 128, VB + (size_t)(b * HKV + kvh) * LPA * 128,
                           MIX + ((size_t)b * SEQ + qb * 256) * DM + h * 128, RSSA + b * SEQ + qb * 256, (char*)lds + RING_OFF); }
#endif
        if (BOTH(3)) GRID_BAR();
    }

    if (IN(4)) {
        for (int ui = F.vcu; ui < (MR / 128) * 4; ui += F.G) { const int tt = ui >> 2, g = ui & 3, b = tt >> 7, t0 = (tt & 127) * 128;
            tg::EpiCM E{MIX, RSSF, b * SEQ + t0, g};
            tg::unit<4, tg::EpiCM>(F.lds + RING_OFF, AB + ((size_t)b * LTOK + NMETA + t0) * 1024 + g * 256, 1024, MG + (size_t)g * 256 * 128, 128, 256, 8, E); }
        if (BOTH(4)) GRID_BAR();
    }

    if (IN(5)) {
        pg8::Gemm g{MIX, WOUT_T, MR, DM, DM}; pg8::StaticOrder S; S.init(MR, DM, F.G, (int)blockIdx.x);
        LAS float* tab = (LAS float*)(F.lds + LDSCTL_OFF + 1024);
        for (int i = 0; i < 8; ++i) { pg8::Unit u; if (!S.next(i, u)) break;
            if (F.tid < 256) { const int row = u.pm * 256 + F.tid; tab[i * 256 + F.tid] = sqrtf(RSSF[row] * (1.0f / 512.0f) + RMS_EPS) / sqrtf(RSSA[row] * (1.0f / 512.0f) + RMS_EPS); } }
        __syncthreads();
        pg8::EpiOutProj E{x, H1, H1B, RSSF, RSSM, tab};
        pg8::gemm_phase<pg8::EpiOutProj, pg8::StaticOrder, true, true>(F.lds + RING_OFF, g, S, E);
        if (BOTH(5)) GRID_BAR();
    }
    if (IN(6)) {
        pg8::Gemm g{H1B, WUP_T, MR, DFF, DM}; pg8::StaticOrder S; S.init(MR, DFF, F.G, (int)blockIdx.x);
        pg8::EpiUp E{HID, RSSM};
        pg8::gemm_phase<pg8::EpiUp, pg8::StaticOrder, true, true>(F.lds + RING_OFF, g, S, E);
        if (BOTH(6)) GRID_BAR();
    }
    if (IN(7)) {
        pg8::Gemm g{HID, WDN_T, MR, DM, DFF}; pg8::StaticOrder S; S.init(MR, DM, F.G, (int)blockIdx.x);
        pg8::EpiDown E{H1, out, RSS2};
        pg8::gemm_phase<pg8::EpiDown, pg8::StaticOrder, true, true>(F.lds + RING_OFF, g, S, E);
        if (BOTH(7)) GRID_BAR();
    }
    if (IN(8)) {
        for (int m = gw; m < MR; m += NGW) {
            const float rstd = 1.f / sqrtf(RSS2[m] * (1.f / DM) + RMS_EPS);
            GAS f32x4* o = (GAS f32x4*)(out + (size_t)m * DM) + F.lane; const GAS f32x4* gr = (const GAS f32x4*)g_final + F.lane;
#pragma unroll
            for (int j = 0; j < 4; ++j) { const f32x4 v = o[64 * j]; o[64 * j] = v * rstd * gr[64 * j]; }
        }
    }
#undef IN
#undef BOTH
}

extern "C" void kernel_launch(void* const* d_in, const int* in_sizes, int n_in, void* d_out, int out_size, void* d_ws, size_t ws_size, hipStream_t stream) {
    static int grid = 0;
    if (grid == 0) {
        if (n_in != 14 || in_sizes[0] != MR * DM || out_size != MR * DM || ws_size < WS_END) { fprintf(stderr, "kernel_launch: unexpected shapes: n_in %d in0 %d out %d ws %zu (need >= %zu)\n", n_in, n_in > 0 ? in_sizes[0] : -1, out_size, ws_size, (size_t)WS_END); grid = -1; return; }
        int dev = 0, cus = 0, per_cu = 0;
        if (hipGetDevice(&dev) != hipSuccess || hipDeviceGetAttribute(&cus, hipDeviceAttributeMultiprocessorCount, dev) != hipSuccess) { fprintf(stderr, "kernel_launch: device query failed\n"); grid = -1; return; }
        if (hipFuncSetAttribute((const void*)hymba_fwd, hipFuncAttributeMaxDynamicSharedMemorySize, LDS_BYTES) != hipSuccess) { fprintf(stderr, "kernel_launch: hipFuncSetAttribute failed\n"); grid = -1; return; }
        if (hipOccupancyMaxActiveBlocksPerMultiprocessor(&per_cu, (const void*)hymba_fwd, NWAVES * 64, LDS_BYTES) != hipSuccess || per_cu < 1) { fprintf(stderr, "kernel_launch: occupancy query says %d blocks per CU\n", per_cu); (void)hipGetLastError(); grid = -1; return; }
        grid = cus;
    }
    if (grid < 0) return;
    if (hipMemsetAsync((char*)d_ws + WS_CTL, 0, CTL_ZERO_BYTES, stream) != hipSuccess) { fprintf(stderr, "kernel_launch: memset failed\n"); return; }
    Args a{};
    for (int i = 0; i < 14; ++i) a.in[i] = (const float*)d_in[i];
    a.out = (float*)d_out; a.ws = (unsigned char*)d_ws;
    for (int li = 0; li < N_LAUNCHES; ++li) {
        a.ph_lo = (N_LAUNCHES == 1) ? 0 : li; a.ph_hi = (N_LAUNCHES == 1) ? N_PHASES : li + 1; a.li = li; a.pad = 0;
        hipLaunchKernelGGL(hymba_fwd, dim3(grid), dim3(NWAVES * 64), LDS_BYTES, stream, a);
        const hipError_t le = hipPeekAtLastError();
        if (le != hipSuccess) { fprintf(stderr, "kernel_launch: launch %d failed: %s\n", li, hipGetErrorName(le)); break; }
    }
}
```

```cpp
#include <hip/hip_runtime.h>
#include <hip/hip_bf16.h>
#include <cstdio>
#include <cstdint>

constexpr int BATCH = 2, SEQ = 16384, DM = 1024, NMETA = 16, LTOK = SEQ + NMETA, HQ = 4, HKV = 2, DFF = 4096, NPROJ = 1536;
constexpr int MR = BATCH * SEQ;
constexpr int MPAD = MR + 256;
constexpr int LPA = 16512;
constexpr int FN1 = 80, FN2 = 205;
constexpr float RMS_EPS = 1e-6f;
namespace pg8 {
#define PG8_LAS __attribute__((address_space(3)))
typedef unsigned short bf16_t;
typedef short bf16x8 __attribute__((ext_vector_type(8)));
typedef float f32x4 __attribute__((ext_vector_type(4)));
typedef unsigned u32x4 __attribute__((ext_vector_type(4)));
constexpr int BM = 256, BK = 64, HALF = 128, HTB = HALF * BK * 2  , STAGE_BYTES = 8 * HTB, NXCD = 8, WGM = 8;

__host__ __device__ __forceinline__ int lds_byte(int r, int c) { const int st = (r >> 4) * 2 + (c >> 5), rr = r & 15, cc = c & 31, ob = rr * 64 + cc * 2; return st * 1024 + (ob ^ (((ob >> 9) & 1) << 5)); }
__host__ __device__ __forceinline__ void stage_rc(int b, int& R, int& C) { const int st = b / 1024, sb = b % 1024, swz = sb ^ (((sb >> 9) & 1) << 5); R = (st >> 1) * 16 + swz / 64; C = (st & 1) * 32 + (swz % 64) / 2; }
__host__ __device__ __forceinline__ int perm32(int rho) { const int n = rho >> 4, i = rho & 15; return 8 * (i >> 2) + 4 * n + (i & 3); }

struct Unit { int pm, pn; };
struct Gemm { const bf16_t* A; const bf16_t* Bt; int M, N, K; };

struct StaticOrder {
    int nM, nN, nwg, G, c;
    __host__ __device__ void init(int M, int N, int G_, int c_) { nM = M / BM; nN = N / BM; nwg = nM * nN; G = G_; c = c_; }
    __host__ __device__ bool next(int i, Unit& u) const {
        const long L = (long)i * G + c; if (L >= nwg) return false;
        int wgid = (int)L; { const int q = nwg / NXCD, r = nwg % NXCD, xcd = wgid % NXCD, off = wgid / NXCD; wgid = (xcd < r ? xcd * (q + 1) : r * (q + 1) + (xcd - r) * q) + off; }
        const int nig = WGM * nN, gid = wgid / nig, fm = gid * WGM, gsz = (nM - fm) < WGM ? (nM - fm) : WGM;
        u.pm = fm + ((wgid % nig) % gsz); u.pn = (wgid % nig) / gsz; return true;
    }
    __device__ __forceinline__ void a_ready(const Unit&) const {}
    __device__ __forceinline__ void done(const Unit&) const {}
};


__device__ __forceinline__ unsigned cvt_pk_bf16(float lo, float hi) { unsigned r; asm volatile("v_cvt_pk_bf16_f32 %0, %1, %2" : "=v"(r) : "v"(lo), "v"(hi)); return r; }
typedef unsigned u32x2 __attribute__((ext_vector_type(2)));
typedef _Float16 f16x4 __attribute__((ext_vector_type(4)));

struct InProjOrder {
    StaticOrder so;
    __device__ void init(int G_, int c_) { so.init(MR, NPROJ, G_, c_); }
    __device__ bool next(int i, Unit& u) const {
        if (so.next(i, u)) return true;
        const long L = (long)i * so.G + so.c - so.nwg; if (L < 0 || L >= 4) return false;
        u.pm = 128; u.pn = 2 + (int)L; return true;
    }
    __device__ __forceinline__ void a_ready(const Unit&) const {}
    __device__ __forceinline__ void done(const Unit&) const {}
};

struct EpiInProj {
    static constexpr bool PERM = false, AFTER_DRAIN = false, MIDK = false;
    float* qkraw; bf16_t* V; _Float16* U;
    __device__ __forceinline__ void operator()(const f32x4 (&acc)[2][2][4][2], const Unit& u, int wr, int wc, int fr, int fq) const {
        const bool meta = (u.pm == 128);
#pragma unroll
        for (int ai = 0; ai < 2; ++ai)
#pragma unroll
            for (int m = 0; m < 4; ++m) {
                const int rl = ai * HALF + wr * 64 + m * 16 + fr, grow = u.pm * BM + rl;
                const bool valid = !meta || rl < NMETA;
                const int b = grow >> 14, t = grow & (SEQ - 1);
                if (u.pn <= 2) {
                    if (valid) { float* p = qkraw + (size_t)grow * 768 + u.pn * BM + wc * 32 + 4 * fq;
#pragma unroll
                        for (int bj = 0; bj < 2; ++bj)
#pragma unroll
                            for (int n = 0; n < 2; ++n) *(f32x4*)(p + bj * HALF + n * 16) = acc[ai][bj][m][n]; }
                } else if (u.pn == 3) {
#pragma unroll
                    for (int bj = 0; bj < 2; ++bj)
#pragma unroll
                        for (int n = 0; n < 2; ++n) { const f32x4 v = acc[ai][bj][m][n]; u32x2 w; w.x = cvt_pk_bf16(v[0], v[1]); w.y = cvt_pk_bf16(v[2], v[3]);
                            const int d = wc * 32 + n * 16 + 4 * fq;
                            if (!meta) *(u32x2*)(V + ((size_t)(b * HKV + bj) * LPA + 64 + t) * 128 + d) = w;
                            else if (valid) { *(u32x2*)(V + ((size_t)(0 * HKV + bj) * LPA + rl) * 128 + d) = w; *(u32x2*)(V + ((size_t)(1 * HKV + bj) * LPA + rl) * 128 + d) = w; } }
                } else {
#pragma unroll
                    for (int bj = 0; bj < 2; ++bj)
#pragma unroll
                        for (int n = 0; n < 2; ++n) { const f32x4 v = acc[ai][bj][m][n]; f16x4 h; h[0] = (_Float16)v[0]; h[1] = (_Float16)v[1]; h[2] = (_Float16)v[2]; h[3] = (_Float16)v[3];
                            const int cu = (u.pn - 4) * BM + bj * HALF + wc * 32 + n * 16 + 4 * fq;
                            if (!meta) *(f16x4*)(U + ((size_t)b * LTOK + NMETA + t) * 512 + cu) = h;
                            else if (valid) { *(f16x4*)(U + ((size_t)0 * LTOK + rl) * 512 + cu) = h; *(f16x4*)(U + ((size_t)1 * LTOK + rl) * 512 + cu) = h; } }
                }
            }
    }
};

struct EpiOutProj {
    static constexpr bool PERM = false, AFTER_DRAIN = false, MIDK = true;
    const float* x; float* H1; bf16_t* H1B; const float* rssf; float* rssm; const PG8_LAS float* tab;
    __device__ __forceinline__ void mid(f32x4 (&acc)[2][2][4][2], int ui, int wr, int fr) const {
        const PG8_LAS float* tp = tab + ui * BM + wr * 64 + fr;
#pragma unroll
        for (int ai = 0; ai < 2; ++ai)
#pragma unroll
            for (int m = 0; m < 4; ++m) { const float ratio = tp[ai * HALF + m * 16];
#pragma unroll
                for (int bj = 0; bj < 2; ++bj)
#pragma unroll
                    for (int n = 0; n < 2; ++n) acc[ai][bj][m][n] = acc[ai][bj][m][n] * ratio; }
    }
    __device__ __forceinline__ void operator()(const f32x4 (&acc)[2][2][4][2], const Unit& u, int wr, int wc, int fr, int fq) const {
        const int col0 = u.pn * BM + wc * 32 + 4 * fq;
#pragma unroll
        for (int ai = 0; ai < 2; ++ai)
#pragma unroll
            for (int m = 0; m < 4; ++m) { const int row = u.pm * BM + ai * HALF + wr * 64 + m * 16 + fr; const size_t off = (size_t)row * DM + col0;
                const float rf = 1.0f / sqrtf(rssf[row] * (1.0f / 512.0f) + RMS_EPS); float ss = 0.f;
#pragma unroll
                for (int bj = 0; bj < 2; ++bj)
#pragma unroll
                    for (int n = 0; n < 2; ++n) { const f32x4 xr = *(const f32x4*)(x + off + bj * HALF + n * 16); const f32x4 v = acc[ai][bj][m][n] * rf + xr;
                        *(f32x4*)(H1 + off + bj * HALF + n * 16) = v; u32x2 w; w.x = cvt_pk_bf16(v[0], v[1]); w.y = cvt_pk_bf16(v[2], v[3]); *(u32x2*)(H1B + off + bj * HALF + n * 16) = w;
                        ss += (v[0] * v[0] + v[1] * v[1]) + (v[2] * v[2] + v[3] * v[3]); }
                ss += __shfl_xor(ss, 16); ss += __shfl_xor(ss, 32);
                if (fq == 0) unsafeAtomicAdd(rssm + row, ss);
                asm volatile("" ::: "memory"); }
    }
};

struct EpiUp {
    static constexpr bool PERM = true, AFTER_DRAIN = false, MIDK = false;
    bf16_t* HID; const float* rssm;
    __device__ __forceinline__ void operator()(const f32x4 (&acc)[2][2][4][2], const Unit& u, int wr, int wc, int fr, int fq) const {
        const int col0 = u.pn * BM + wc * 32 + 8 * fq;
#pragma unroll
        for (int ai = 0; ai < 2; ++ai)
#pragma unroll
            for (int m = 0; m < 4; ++m) { const int row = u.pm * BM + ai * HALF + wr * 64 + m * 16 + fr; bf16_t* rowp = HID + (size_t)row * DFF + col0;
                const float rs = 1.0f / sqrtf(rssm[row] * (1.0f / 1024.0f) + RMS_EPS);
#pragma unroll
                for (int bj = 0; bj < 2; ++bj) { f32x4 v0 = acc[ai][bj][m][0] * rs, v1 = acc[ai][bj][m][1] * rs;
#pragma unroll
                    for (int e = 0; e < 4; ++e) { const float a = fmaxf(v0[e], 0.f), b = fmaxf(v1[e], 0.f); v0[e] = a * a; v1[e] = b * b; }
                    u32x4 w; w.x = cvt_pk_bf16(v0[0], v0[1]); w.y = cvt_pk_bf16(v0[2], v0[3]); w.z = cvt_pk_bf16(v1[0], v1[1]); w.w = cvt_pk_bf16(v1[2], v1[3]);
                    *(u32x4*)(rowp + bj * HALF) = w; } }
    }
};

struct EpiDown {
    static constexpr bool PERM = false, AFTER_DRAIN = false, MIDK = false;
    const float* H1; float* out; float* rss2;
    __device__ __forceinline__ void operator()(const f32x4 (&acc)[2][2][4][2], const Unit& u, int wr, int wc, int fr, int fq) const {
        const int col0 = u.pn * BM + wc * 32 + 4 * fq;
#pragma unroll
        for (int ai = 0; ai < 2; ++ai)
#pragma unroll
            for (int m = 0; m < 4; ++m) { const int row = u.pm * BM + ai * HALF + wr * 64 + m * 16 + fr; const size_t off = (size_t)row * DM + col0; float ss = 0.f;
#pragma unroll
                for (int bj = 0; bj < 2; ++bj)
#pragma unroll
                    for (int n = 0; n < 2; ++n) { const f32x4 hr = *(const f32x4*)(H1 + off + bj * HALF + n * 16); const f32x4 v = acc[ai][bj][m][n] + hr;
                        *(f32x4*)(out + off + bj * HALF + n * 16) = v; ss += (v[0] * v[0] + v[1] * v[1]) + (v[2] * v[2] + v[3] * v[3]); }
                ss += __shfl_xor(ss, 16); ss += __shfl_xor(ss, 32);
                if (fq == 0) unsafeAtomicAdd(rss2 + row, ss);
                asm volatile("" ::: "memory"); }
    }
};

template <class Epi, class Sched, bool ALIGN_EPI = false, bool SP2 = false>
__device__ __forceinline__ void gemm_phase(PG8_LAS unsigned char* lds, const Gemm g, const Sched& S, const Epi& E) {
    const int tid = threadIdx.x, wid = __builtin_amdgcn_readfirstlane(tid >> 6), lane = tid & 63, wr = wid >> 2, wc = wid & 3, fr = lane & 15, fq = lane >> 4;
    const int K = g.K, nt = K / BK;
    unsigned voffA[2], voffB[2];
#pragma unroll
    for (int i = 0; i < 2; ++i) { int R, C; stage_rc(tid * 16 + i * 8192, R, C); const int Rb = Epi::PERM ? ((R & ~31) + perm32(R & 31)) : R;
        voffA[i] = (unsigned)(R * K + C) * 2u; voffB[i] = (unsigned)(Rb * K + C) * 2u; }
    const size_t kstep = (size_t)(BK * 2);
    const size_t hstep = (size_t)HALF * K * 2;
    const size_t tstep = 2 * hstep;
    const unsigned ldsw = (unsigned)wid * 1024u;
    const int aoff = lds_byte(wr * 64 + fr, fq * 8), boff = lds_byte(wc * 32 + fr, fq * 8);
#define PG8_SA(b, h) (((b) * 2 + (h)) * HTB)
#define PG8_SB(b, h) ((4 + (b) * 2 + (h)) * HTB)
#define PG8_STAGE(bufoff, gbase, voff) do { _Pragma("unroll") for (int _i = 0; _i < 2; ++_i) \
        __builtin_amdgcn_global_load_lds((const unsigned*)((const char*)(gbase) + (voff)[_i]), (PG8_LAS unsigned*)(lds + (bufoff) + ldsw + _i * 8192), 16, 0, 0); } while (0)
#define PG8_LDA(dst, b, h) do { _Pragma("unroll") for (int m = 0; m < 4; ++m) _Pragma("unroll") for (int k = 0; k < 2; ++k) dst[m][k] = *(const PG8_LAS bf16x8*)(lds + PG8_SA(b, h) + aoff + m * 2048 + k * 1024); } while (0)
#define PG8_LDB(dst, b, h) do { _Pragma("unroll") for (int n = 0; n < 2; ++n) _Pragma("unroll") for (int k = 0; k < 2; ++k) dst[n][k] = *(const PG8_LAS bf16x8*)(lds + PG8_SB(b, h) + boff + n * 2048 + k * 1024); } while (0)
#define PG8_MMA(ai, bj, At, Bt) do { __builtin_amdgcn_s_setprio(1); _Pragma("unroll") for (int m = 0; m < 4; ++m) _Pragma("unroll") for (int n = 0; n < 2; ++n) _Pragma("unroll") for (int k = 0; k < 2; ++k) \
        acc[ai][bj][m][n] = __builtin_amdgcn_mfma_f32_16x16x32_bf16(Bt[n][k], At[m][k], acc[ai][bj][m][n], 0, 0, 0); __builtin_amdgcn_s_setprio(0); } while (0)
#define PG8_WAIT_V(n) asm volatile("s_waitcnt vmcnt(" #n ")" ::: "memory")
#define PG8_WAIT_L(n) asm volatile("s_waitcnt lgkmcnt(" #n ")" ::: "memory")
#define PG8_BAR __builtin_amdgcn_s_barrier()
#define PG8_SCHED __builtin_amdgcn_sched_barrier(0)
    Unit cur, nxt; int ui = 0;
    if (!S.next(0, cur)) return;
    f32x4 acc[2][2][4][2];
#pragma unroll
    for (int a = 0; a < 2; ++a)
#pragma unroll
        for (int b = 0; b < 2; ++b)
#pragma unroll
            for (int m = 0; m < 4; ++m)
#pragma unroll
                for (int n = 0; n < 2; ++n) acc[a][b][m][n] = (f32x4){0.f, 0.f, 0.f, 0.f};
    bf16x8 At[4][2], B0[2][2], B1[2][2];
    const char* cA = (const char*)g.A + (size_t)cur.pm * tstep; const char* cB = (const char*)g.Bt + (size_t)cur.pn * tstep;
    S.a_ready(cur);
    if constexpr (SP2) {
        PG8_STAGE(PG8_SB(0, 0), cB, voffB); PG8_STAGE(PG8_SB(0, 1), cB + hstep, voffB); PG8_STAGE(PG8_SA(0, 0), cA, voffA); PG8_STAGE(PG8_SA(0, 1), cA + hstep, voffA);
        if (wr == 1) PG8_BAR;
        PG8_WAIT_V(2); PG8_BAR;
        PG8_STAGE(PG8_SB(1, 0), cB + kstep, voffB); PG8_STAGE(PG8_SA(1, 0), cA + kstep, voffA); PG8_STAGE(PG8_SB(1, 1), cB + hstep + kstep, voffB);
        PG8_WAIT_V(6); PG8_BAR;
    } else {
        PG8_STAGE(PG8_SB(0, 0), cB, voffB); PG8_STAGE(PG8_SA(0, 0), cA, voffA); PG8_STAGE(PG8_SB(0, 1), cB + hstep, voffB); PG8_STAGE(PG8_SA(0, 1), cA + hstep, voffA);
        if (wr == 1) PG8_BAR;
        PG8_WAIT_V(4); PG8_BAR;
        PG8_STAGE(PG8_SB(1, 0), cB + kstep, voffB); PG8_STAGE(PG8_SA(1, 0), cA + kstep, voffA); PG8_STAGE(PG8_SB(1, 1), cB + hstep + kstep, voffB);
        PG8_WAIT_V(6); PG8_BAR;
    }
    for (;;) {
        const bool has_next = S.next(ui + 1, nxt);
        const char* nA = has_next ? (const char*)g.A + (size_t)nxt.pm * tstep : cA; const char* nB = has_next ? (const char*)g.Bt + (size_t)nxt.pn * tstep : cB;
        for (int t = 0; t < nt; t += 2) {
            const bool last = (t == nt - 2);
            if constexpr (Epi::MIDK) { if (t == (nt >> 1)) E.mid(acc, ui, wr, fr); }
            const char* a1 = cA + (size_t)(t + 1) * kstep;
            const char* a2 = last ? nA : cA + (size_t)(t + 2) * kstep; const char* b2 = last ? nB : cB + (size_t)(t + 2) * kstep;
            const char* a3 = a2 + kstep; const char* b3 = b2 + kstep;
            if (last && has_next) S.a_ready(nxt);
            if constexpr (SP2) {
            PG8_LDB(B0, 0, 0); PG8_LDB(B1, 0, 1); PG8_SCHED; PG8_LDA(At, 0, 0); PG8_STAGE(PG8_SA(1, 1), a1 + hstep, voffA);
            PG8_WAIT_V(8); PG8_WAIT_L(0); PG8_BAR; PG8_MMA(0, 0, At, B0); PG8_MMA(0, 1, At, B1); PG8_BAR; PG8_SCHED;
            PG8_LDA(At, 0, 1); PG8_STAGE(PG8_SB(0, 0), b2, voffB); PG8_STAGE(PG8_SB(0, 1), b2 + hstep, voffB); PG8_STAGE(PG8_SA(0, 0), a2, voffA);
            PG8_WAIT_V(8); PG8_WAIT_L(0); PG8_BAR; PG8_MMA(1, 0, At, B0); PG8_MMA(1, 1, At, B1); PG8_BAR; PG8_SCHED;
            PG8_LDB(B0, 1, 0); PG8_LDB(B1, 1, 1); PG8_SCHED; PG8_LDA(At, 1, 0); PG8_STAGE(PG8_SA(0, 1), a2 + hstep, voffA);
            PG8_WAIT_V(8); PG8_WAIT_L(0); PG8_BAR; PG8_MMA(0, 0, At, B0); PG8_MMA(0, 1, At, B1); PG8_BAR; PG8_SCHED;
            PG8_LDA(At, 1, 1); PG8_STAGE(PG8_SB(1, 0), b3, voffB); PG8_STAGE(PG8_SB(1, 1), b3 + hstep, voffB); PG8_STAGE(PG8_SA(1, 0), a3, voffA);
            PG8_WAIT_V(8); PG8_WAIT_L(0); PG8_BAR; PG8_MMA(1, 0, At, B0); PG8_MMA(1, 1, At, B1); PG8_BAR; PG8_SCHED;
            } else {
            PG8_LDB(B0, 0, 0); PG8_SCHED; PG8_LDA(At, 0, 0); PG8_STAGE(PG8_SA(1, 1), a1 + hstep, voffA);
            PG8_WAIT_L(8); PG8_BAR; PG8_WAIT_L(0); PG8_MMA(0, 0, At, B0); PG8_BAR; PG8_SCHED;
            PG8_LDB(B1, 0, 1); PG8_STAGE(PG8_SB(0, 0), b2, voffB);
            PG8_BAR; PG8_WAIT_L(0); PG8_MMA(0, 1, At, B1); PG8_BAR;
            PG8_LDA(At, 0, 1); PG8_STAGE(PG8_SA(0, 0), a2, voffA);
            PG8_BAR; PG8_WAIT_L(0); PG8_MMA(1, 0, At, B0); PG8_BAR; PG8_SCHED;
            PG8_STAGE(PG8_SB(0, 1), b2 + hstep, voffB);
            PG8_WAIT_V(6); PG8_BAR; PG8_MMA(1, 1, At, B1); PG8_BAR;
            PG8_LDB(B0, 1, 0); PG8_SCHED; PG8_LDA(At, 1, 0); PG8_STAGE(PG8_SA(0, 1), a2 + hstep, voffA);
            PG8_WAIT_L(8); PG8_BAR; PG8_WAIT_L(0); PG8_MMA(0, 0, At, B0); PG8_BAR; PG8_SCHED;
            PG8_LDB(B1, 1, 1); PG8_STAGE(PG8_SB(1, 0), b3, voffB);
            PG8_BAR; PG8_WAIT_L(0); PG8_MMA(0, 1, At, B1); PG8_BAR;
            PG8_LDA(At, 1, 1); PG8_STAGE(PG8_SA(1, 0), a3, voffA);
            PG8_BAR; PG8_WAIT_L(0); PG8_MMA(1, 0, At, B0); PG8_BAR; PG8_SCHED;
            PG8_STAGE(PG8_SB(1, 1), b3 + hstep, voffB);
            PG8_WAIT_V(6); PG8_BAR; PG8_MMA(1, 1, At, B1); PG8_BAR;
            }
        }
        if constexpr (ALIGN_EPI) { if (wr == 0) PG8_BAR; }
        if constexpr (!Epi::AFTER_DRAIN) { E(acc, cur, wr, wc, fr, fq); S.done(cur); }
        if (!has_next) break;
#pragma unroll
        for (int a = 0; a < 2; ++a)
#pragma unroll
            for (int b = 0; b < 2; ++b)
#pragma unroll
                for (int m = 0; m < 4; ++m)
#pragma unroll
                    for (int n = 0; n < 2; ++n) acc[a][b][m][n] = (f32x4){0.f, 0.f, 0.f, 0.f};
        cur = nxt; cA = nA; cB = nB; ++ui;
        if constexpr (ALIGN_EPI) { if (wr == 1) PG8_BAR; }
    }
    PG8_WAIT_V(0);
    if constexpr (!ALIGN_EPI) { if (wr == 0) PG8_BAR; }
    PG8_BAR;
    if constexpr (Epi::AFTER_DRAIN) { E.fused(acc, cur, wr, wc, fr, fq, lds, wid, lane); S.done(cur); }
#undef PG8_SA
#undef PG8_SB
#undef PG8_STAGE
#undef PG8_LDA
#undef PG8_LDB
#undef PG8_MMA
#undef PG8_WAIT_V
#undef PG8_WAIT_L
#undef PG8_BAR
#undef PG8_SCHED
}
}
namespace att {
using bf16x8 = __attribute__((ext_vector_type(8))) short;
using s16x4  = __attribute__((ext_vector_type(4))) short;
using f32x16 = __attribute__((ext_vector_type(16))) float;
using u32x4  = __attribute__((ext_vector_type(4))) unsigned;
constexpr int D = 128, NW = 8, QBLK = 32, KVBLK = 64, NT = 257;
constexpr float SCALE = 0.088388347648318440f;
constexpr float THR = 8.f;
constexpr int LDQ = D, LDK = D;
constexpr size_t SHM_V = KVBLK * D * 2, SHM_K = KVBLK * D * 2, SHM_ATTN = 2 * SHM_V + 2 * SHM_K + NW * 64 * 4;
#define KSWZ(row, colB) ((row) * 256 + ((colB) ^ (((row) & 7) << 4)))
#define SBAR() __builtin_amdgcn_sched_barrier(0)
__device__ __forceinline__ int crow(int r, int hi) { return (r & 3) + 8 * (r >> 2) + 4 * hi; }
__device__ __forceinline__ unsigned cvtpk(float lo, float hi) { unsigned r; asm volatile("v_cvt_pk_bf16_f32 %0, %1, %2" : "=v"(r) : "v"(lo), "v"(hi)); return r; }

__device__ __forceinline__ void startSM(f32x16& p0, float nm) {
  for (int r = 0; r < 16; ++r) p0[r] = __builtin_amdgcn_exp2f(p0[r] + nm);
}
__device__ __forceinline__ void finishSM(f32x16& p0, f32x16& p1, float nm, float& l_reg, bf16x8& pa0, bf16x8& pa1, bf16x8& pa2, bf16x8& pa3) {
  for (int r = 0; r < 16; ++r) p1[r] = __builtin_amdgcn_exp2f(p1[r] + nm);
  float ps = 0; for (int r = 0; r < 16; ++r) ps += p0[r]; for (int r = 0; r < 16; ++r) ps += p1[r];
  l_reg += ps;
#define PK4(P, BASE, OUT) do { unsigned a0 = cvtpk(P[BASE + 0], P[BASE + 1]), a1 = cvtpk(P[BASE + 2], P[BASE + 3]);   \
    unsigned b0 = cvtpk(P[BASE + 4], P[BASE + 5]), b1 = cvtpk(P[BASE + 6], P[BASE + 7]);                              \
    auto r0 = __builtin_amdgcn_permlane32_swap(a0, b0, false, false); auto r1 = __builtin_amdgcn_permlane32_swap(a1, b1, false, false); \
    u32x4 w = {r0[0], r1[0], r0[1], r1[1]}; OUT = *reinterpret_cast<bf16x8*>(&w); } while (0)
  PK4(p0, 0, pa0); PK4(p0, 8, pa1); PK4(p1, 0, pa2); PK4(p1, 8, pa3);
#undef PK4
}
__device__ __forceinline__ void qkt(f32x16& p0, f32x16& p1, const unsigned short* Ks, const bf16x8* qr, int r32, int hi) {
  p0 = f32x16{}; p1 = f32x16{};
  for (int d0 = 0; d0 < 8; ++d0) { int cb = (d0 * 16 + hi * 8) * 2;
    bf16x8 b0 = *reinterpret_cast<const bf16x8*>((const char*)Ks + KSWZ(r32, cb));
    bf16x8 b1 = *reinterpret_cast<const bf16x8*>((const char*)Ks + KSWZ(32 + r32, cb));
    p0 = __builtin_amdgcn_mfma_f32_32x32x16_bf16(b0, qr[d0], p0, 0, 0, 0);
    p1 = __builtin_amdgcn_mfma_f32_32x32x16_bf16(b1, qr[d0], p1, 0, 0, 0); }
}
__device__ __forceinline__ int v_st(int k, int c) { const int kk = (k & ~0xC) | ((k & 4) << 1) | ((k & 8) >> 1); return ((kk >> 3) * 4 + (c >> 5)) * 512 + ((kk & 7) * 32 + (c & 31)) * 2; }
__device__ __forceinline__ int v_rd_base(int lane) { return ((lane & 3) << 3) | (((lane >> 2) & 3) << 6) | (((lane >> 4) & 1) << 5) | (((lane >> 5) & 1) << 8); }
constexpr int v_rd_off(int d0, int ks, int half) { return d0 * 512 + ks * 4096 + half * 2048; }
template <int OFF> __device__ __forceinline__ s16x4 tr_read(int vb) {
  s16x4 r; asm volatile("ds_read_b64_tr_b16 %0, %1 offset:%2" : "=&v"(r) : "v"(vb), "i"(OFF) : "memory"); return r;
}
template <int D0> __device__ __forceinline__ void pv_one(f32x16& od, int vb, bf16x8 pa0, bf16x8 pa1, bf16x8 pa2, bf16x8 pa3) {
  const s16x4 l0 = tr_read<v_rd_off(D0, 0, 0)>(vb), h0 = tr_read<v_rd_off(D0, 0, 1)>(vb), l1 = tr_read<v_rd_off(D0, 1, 0)>(vb), h1 = tr_read<v_rd_off(D0, 1, 1)>(vb);
  const s16x4 l2 = tr_read<v_rd_off(D0, 2, 0)>(vb), h2 = tr_read<v_rd_off(D0, 2, 1)>(vb), l3 = tr_read<v_rd_off(D0, 3, 0)>(vb), h3 = tr_read<v_rd_off(D0, 3, 1)>(vb);
  asm volatile("s_waitcnt lgkmcnt(0)" ::: "memory"); SBAR();
#define PK(L, H) (bf16x8){L[0], L[1], L[2], L[3], H[0], H[1], H[2], H[3]}
  od = __builtin_amdgcn_mfma_f32_32x32x16_bf16(pa0, PK(l0, h0), od, 0, 0, 0);
  od = __builtin_amdgcn_mfma_f32_32x32x16_bf16(pa1, PK(l1, h1), od, 0, 0, 0);
  od = __builtin_amdgcn_mfma_f32_32x32x16_bf16(pa2, PK(l2, h2), od, 0, 0, 0);
  od = __builtin_amdgcn_mfma_f32_32x32x16_bf16(pa3, PK(l3, h3), od, 0, 0, 0);
#undef PK
}
__device__ __forceinline__ void pv_d0(f32x16* o, int vb, bf16x8 pa0, bf16x8 pa1, bf16x8 pa2, bf16x8 pa3) {
  pv_one<0>(o[0], vb, pa0, pa1, pa2, pa3); pv_one<1>(o[1], vb, pa0, pa1, pa2, pa3); pv_one<2>(o[2], vb, pa0, pa1, pa2, pa3); pv_one<3>(o[3], vb, pa0, pa1, pa2, pa3);
}

__device__ __forceinline__ void attn_unit(const unsigned short* __restrict__ Qb, const unsigned short* __restrict__ Kh, const unsigned short* __restrict__ Vh,
                                          unsigned short* __restrict__ Ob, float* __restrict__ rss, const float* __restrict__ qn, float kmax, char* lds) {
  int tid_ = threadIdx.x; asm volatile("" : "+v"(tid_));
  const int tid = tid_, wid = tid >> 6, lane = tid & 63, r32 = lane & 31, hi = lane >> 5;
  unsigned short* V_lds = (unsigned short*)lds; unsigned short* K_lds = (unsigned short*)(lds + 2 * SHM_V);
  float* ws = (float*)(lds + 2 * SHM_V + 2 * SHM_K) + wid * 64; float* li_l = ws;
  float l_reg = 0; f32x16 o[4] = {}; bf16x8 qr[8];
  const float nm = -qn[wid * QBLK + r32] * kmax;
  const unsigned short* Qw = Qb + (long)(wid * QBLK + r32) * LDQ + hi * 8;
#pragma unroll
  for (int d0 = 0; d0 < 8; ++d0) qr[d0] = *reinterpret_cast<const bf16x8*>(Qw + d0 * 16);
  const int sr = tid >> 4, sc = (tid & 15) * 8, vst0 = v_st(sr, sc), vst1 = v_st(32 + sr, sc);
  const int vb0 = (int)(uintptr_t)V_lds + v_rd_base(lane);
  struct { bf16x8 vs0, vs1, ks0, ks1; } sr_[1];
#define SLOAD(i, k0) do { sr_[i].vs0 = *reinterpret_cast<const bf16x8*>(&Vh[(long)((k0) + sr) * LDK + sc]); sr_[i].vs1 = *reinterpret_cast<const bf16x8*>(&Vh[(long)((k0) + 32 + sr) * LDK + sc]); \
    sr_[i].ks0 = *reinterpret_cast<const bf16x8*>(&Kh[(long)((k0) + sr) * LDK + sc]); sr_[i].ks1 = *reinterpret_cast<const bf16x8*>(&Kh[(long)((k0) + 32 + sr) * LDK + sc]); } while (0)
#define SWRITE(b, i) do { *(bf16x8*)((char*)V_lds + (b) * SHM_V + vst0) = sr_[i].vs0;          \
    *(bf16x8*)((char*)V_lds + (b) * SHM_V + vst1) = sr_[i].vs1; int kc = sc * 2;               \
    *(bf16x8*)((char*)K_lds + (b) * SHM_K + KSWZ(sr, kc)) = sr_[i].ks0;                       \
    *(bf16x8*)((char*)K_lds + (b) * SHM_K + KSWZ(32 + sr, kc)) = sr_[i].ks1; } while (0)
#define SWAIT() asm volatile("s_waitcnt vmcnt(0)" ::: "memory")
  f32x16 pA0, pA1, pB0, pB1; bf16x8 pa0, pa1, pa2, pa3;
  constexpr int SE = 0, SO = 0;
  SLOAD(SE, 0); asm volatile("s_waitcnt vmcnt(0)" ::: "memory"); SWRITE(0, SE); __syncthreads();
  qkt(pA0, pA1, K_lds, qr, r32, hi);
#ifndef ATT_NOMASK
#pragma unroll
  for (int r = 8; r < 16; ++r) pA0[r] = -1e30f;
#pragma unroll
  for (int r = 0; r < 16; ++r) pA1[r] = -1e30f;
#endif
  startSM(pA0, nm);
  SLOAD(SO, KVBLK);
  SWAIT(); SWRITE(1, SO); __syncthreads();
  for (int j = 1; j + 1 < NT; j += 2) {
    SBAR(); qkt(pB0, pB1, (unsigned short*)((char*)K_lds + SHM_K), qr, r32, hi);
    finishSM(pA0, pA1, nm, l_reg, pa0, pa1, pa2, pa3); SBAR();
    SLOAD(SE, (j + 1) * KVBLK); SBAR();
    pv_d0(o, vb0, pa0, pa1, pa2, pa3); startSM(pB0, nm);
    __syncthreads(); SWAIT(); SWRITE(0, SE);
    __syncthreads();
    SBAR(); qkt(pA0, pA1, K_lds, qr, r32, hi);
    finishSM(pB0, pB1, nm, l_reg, pa0, pa1, pa2, pa3); SBAR();
    SLOAD(SO, (j + 2) * KVBLK); SBAR();
    pv_d0(o, vb0 + (int)SHM_V, pa0, pa1, pa2, pa3); startSM(pA0, nm);
    __syncthreads(); SWAIT(); SWRITE(1, SO);
    __syncthreads();
  }
  finishSM(pA0, pA1, nm, l_reg, pa0, pa1, pa2, pa3); SBAR();
  pv_d0(o, vb0, pa0, pa1, pa2, pa3);
  { auto rr = __builtin_amdgcn_permlane32_swap(__float_as_uint(l_reg), __float_as_uint(l_reg), false, false); l_reg = __uint_as_float(rr[0]) + __uint_as_float(rr[1]); }
  if (hi == 0) li_l[r32] = l_reg; asm volatile("s_waitcnt lgkmcnt(0)" ::: "memory");
  float rli[16];
#pragma unroll
  for (int r = 0; r < 16; ++r) rli[r] = __builtin_amdgcn_rcpf(li_l[crow(r, hi)]);
#ifdef ATT_NOSS
  unsigned short* Ow = Ob + (long)(wid * QBLK) * DM;
#pragma unroll
  for (int r = 0; r < 16; ++r) { const int orow = crow(r, hi);
    for (int d0 = 0; d0 < 4; ++d0) { const float v = o[d0][r] * rli[r]; const unsigned u = __float_as_uint(v); Ow[(long)orow * DM + d0 * 32 + r32] = (unsigned short)((u + 0x7fffu + ((u >> 16) & 1u)) >> 16); } }
#else
  unsigned short* Ow = Ob + (long)(wid * QBLK) * DM;
#pragma unroll
  for (int r = 0; r < 16; ++r) { const int orow = crow(r, hi); float ss = 0.f;
#pragma unroll
    for (int d0 = 0; d0 < 4; ++d0) { const float v = o[d0][r] * rli[r]; ss += v * v;
      const unsigned u = __float_as_uint(v); Ow[(long)orow * DM + d0 * 32 + r32] = (unsigned short)((u + 0x7fffu + ((u >> 16) & 1u)) >> 16); }
    ss += __shfl_xor(ss, 1); ss += __shfl_xor(ss, 2); ss += __shfl_xor(ss, 4); ss += __shfl_xor(ss, 8); ss += __shfl_xor(ss, 16);
    if (r32 == 0) unsafeAtomicAdd(rss + wid * QBLK + orow, ss); }
#endif
  __syncthreads();
#undef SLOAD
#undef SWRITE
#undef SWAIT
}
#undef KSWZ
#undef SBAR
}
namespace tg {
#define TG_LAS __attribute__((address_space(3)))
typedef _Float16 f16x8 __attribute__((ext_vector_type(8)));
typedef _Float16 f16x4 __attribute__((ext_vector_type(4)));
typedef short s16x4 __attribute__((ext_vector_type(4)));
typedef float f32x4 __attribute__((ext_vector_type(4)));
typedef unsigned u32x4 __attribute__((ext_vector_type(4)));
constexpr int APITCH = 80, BN = 128, BPITCH = BN * 2 + 32;
template <int MT> struct Cfg { static constexpr int BM = 32 * MT, ABYTES = BM * APITCH, BBYTES = 32 * BPITCH, NPA = (BM * 4 + 511) / 512, LDS_BYTES = 2 * (ABYTES + BBYTES); };

template <int MT, class Epi>
__device__ __forceinline__ void unit(TG_LAS unsigned char* lds, const _Float16* __restrict__ A, int lda, const _Float16* __restrict__ Bp, long ldb, int kvalid, int ksteps, const Epi& E) {
    typedef Cfg<MT> C;
    int tid_ = threadIdx.x; asm volatile("" : "+v"(tid_));
    const int tid = tid_, lane = tid & 63, wid = __builtin_amdgcn_readfirstlane(tid >> 6), wm = wid >> 2, wn = wid & 3;
    f32x4 acc[MT][2];
#pragma unroll
    for (int m = 0; m < MT; ++m) { acc[m][0] = (f32x4){0.f, 0.f, 0.f, 0.f}; acc[m][1] = (f32x4){0.f, 0.f, 0.f, 0.f}; }
    u32x4 ra[C::NPA], rb;
    const int brow = tid >> 4, bch = tid & 15;
#define TG_LOAD(kt) do { _Pragma("unroll") for (int p = 0; p < C::NPA; ++p) { const int idx = tid + 512 * p; \
            if (idx < C::BM * 4) ra[p] = *(const u32x4*)(A + (size_t)(idx >> 2) * lda + (kt) * 32 + (idx & 3) * 8); } \
        { const int k = (kt) * 32 + brow; rb = (u32x4){0u, 0u, 0u, 0u}; if (k < kvalid) rb = *(const u32x4*)(Bp + (size_t)k * ldb + bch * 8); } } while (0)
#define TG_STORE(buf) do { _Pragma("unroll") for (int p = 0; p < C::NPA; ++p) { const int idx = tid + 512 * p; \
            if (idx < C::BM * 4) *(TG_LAS u32x4*)(lds + (buf) * C::ABYTES + (idx >> 2) * APITCH + (idx & 3) * 16) = ra[p]; } \
        *(TG_LAS u32x4*)(lds + 2 * C::ABYTES + (buf) * C::BBYTES + brow * BPITCH + bch * 16) = rb; } while (0)
    const int aoff = (wm * 16 * MT + (lane & 15)) * APITCH + (lane >> 4) * 16;
    const int boff = (8 * (lane >> 4) + ((lane >> 2) & 3)) * BPITCH + (wn * 32 + 4 * (lane & 3)) * 2;
    TG_LOAD(0); TG_STORE(0); __syncthreads();
    for (int kt = 0; kt < ksteps; ++kt) {
        const int buf = kt & 1;
        if (kt + 1 < ksteps) TG_LOAD(kt + 1);
        f16x8 af[MT], bfr[2];
#pragma unroll
        for (int m = 0; m < MT; ++m) af[m] = *(const TG_LAS f16x8*)(lds + buf * C::ABYTES + aoff + m * 16 * APITCH);
#pragma unroll
        for (int n = 0; n < 2; ++n) { const TG_LAS unsigned char* bp = lds + 2 * C::ABYTES + buf * C::BBYTES + boff + n * 32;
            const s16x4 lo = __builtin_amdgcn_ds_read_tr16_b64_v4i16((TG_LAS s16x4*)bp), hi = __builtin_amdgcn_ds_read_tr16_b64_v4i16((TG_LAS s16x4*)(bp + 4 * BPITCH));
            const f16x4 l4 = __builtin_bit_cast(f16x4, lo), h4 = __builtin_bit_cast(f16x4, hi);
            bfr[n] = (f16x8){l4[0], l4[1], l4[2], l4[3], h4[0], h4[1], h4[2], h4[3]}; }
#pragma unroll
        for (int m = 0; m < MT; ++m)
#pragma unroll
            for (int n = 0; n < 2; ++n) acc[m][n] = __builtin_amdgcn_mfma_f32_16x16x32_f16(af[m], bfr[n], acc[m][n], 0, 0, 0);
        if (kt + 1 < ksteps) TG_STORE(buf ^ 1);
        __syncthreads();
    }
    E(acc, wm, wn, lane);
#undef TG_LOAD
#undef TG_STORE
}

struct EpiS1 {
    const float2* TW; _Float16* T1; int b, l2, c0;
    __device__ __forceinline__ void operator()(const f32x4 (&acc)[5][2], int wm, int wn, int lane) const {
        const int g = lane >> 4, cl = lane & 15;
#pragma unroll
        for (int m = 0; m < 5; ++m) { const int k1a = wm * 40 + 8 * m + 2 * g;
            const float2 t0 = TW[k1a * FN2 + l2], t1 = TW[(k1a + 1) * FN2 + l2];
#pragma unroll
            for (int n = 0; n < 2; ++n) { const int col = c0 + wn * 32 + 16 * n + cl; const f32x4 a = acc[m][n];
                _Float16* p0 = T1 + ((((size_t)b * FN1 + k1a) * FN2 + l2) * 2) * 512 + col; _Float16* p1 = p0 + (size_t)FN2 * 2 * 512;
                p0[0] = (_Float16)(a[0] * t0.x + a[1] * t0.y); p0[512] = (_Float16)(a[1] * t0.x - a[0] * t0.y);
                p1[0] = (_Float16)(a[2] * t1.x + a[3] * t1.y); p1[512] = (_Float16)(a[3] * t1.x - a[2] * t1.y); } }
    }
};
struct EpiS2 {
    _Float16* AB; int b, k1, q4;
    __device__ __forceinline__ void operator()(const f32x4 (&acc)[13][2], int wm, int wn, int lane) const {
        const int g = lane >> 4, cl = lane & 15;
#pragma unroll
        for (int m = 0; m < 13; ++m) { const int k2a = wm * 104 + 8 * m + 2 * g;
#pragma unroll
            for (int rr = 0; rr < 2; ++rr) { const int k2 = k2a + rr;
                if (k2 < FN2) { const int tok = k1 + FN1 * k2; _Float16* p = AB + ((((size_t)b * LTOK + tok) * 4 + q4) * 2) * 128 + wn * 32 + cl;
#pragma unroll
                    for (int n = 0; n < 2; ++n) { p[16 * n] = (_Float16)(acc[m][n][2 * rr] * (1.0f / 128.0f)); p[128 + 16 * n] = (_Float16)(acc[m][n][2 * rr + 1] * (1.0f / 128.0f)); } } } }
    }
};
struct EpiCM {
    unsigned short* MIX; float* rssf; int row0, g;
    __device__ __forceinline__ void operator()(const f32x4 (&acc)[4][2], int wm, int wn, int lane) const {
        const int gq = lane >> 4, cl = lane & 15;
#pragma unroll
        for (int m = 0; m < 4; ++m)
#pragma unroll
            for (int r = 0; r < 4; ++r) { const int row = row0 + wm * 64 + 16 * m + 4 * gq + r; float ss = 0.f;
                unsigned short* p = MIX + (size_t)row * DM + 512 + g * 128 + wn * 32 + cl;
#pragma unroll
                for (int n = 0; n < 2; ++n) { const float v = acc[m][n][r]; ss += v * v; const unsigned u = __float_as_uint(v); p[16 * n] = (unsigned short)((u + 0x7fffu + ((u >> 16) & 1u)) >> 16); }
                ss += __shfl_xor(ss, 1); ss += __shfl_xor(ss, 2); ss += __shfl_xor(ss, 4); ss += __shfl_xor(ss, 8);
                if (cl == 0) unsafeAtomicAdd(rssf + row, ss); }
    }
};
}
constexpr int NWAVES = 8;
#ifndef MK_N_LAUNCHES
#define MK_N_LAUNCHES 1
#endif
constexpr int N_PHASES = 9;
constexpr int N_LAUNCHES = MK_N_LAUNCHES;

constexpr size_t MiB = 1u << 20;
constexpr size_t WS_CTL = 0, CTL_ZERO_BYTES = 2 * MiB;
constexpr size_t WS_RSSA = 1 * MiB, WS_RSSF = WS_RSSA + 128 * 1024, WS_RSSM = WS_RSSF + 128 * 1024, WS_RSS2 = WS_RSSM + 128 * 1024;
constexpr size_t WS_WIN = 2 * MiB, WS_WOUT = 5 * MiB, WS_WUP = 7 * MiB, WS_WDN = 15 * MiB;
constexpr size_t WS_TAB = 23 * MiB;
constexpr size_t WS_ROPE = WS_TAB, WS_W1 = WS_TAB + 128 * 1024, WS_W2 = WS_TAB + 192 * 1024, WS_TW = WS_TAB + 576 * 1024, WS_MG = WS_TAB + 768 * 1024;
constexpr size_t WS_HID = 24 * MiB;
constexpr size_t WS_MIX = WS_HID, WS_Q = WS_HID + 64 * MiB, WS_K = WS_HID + 96 * MiB, WS_V = WS_HID + 113 * MiB, WS_U = WS_HID + 130 * MiB, WS_T1 = WS_HID + 163 * MiB;
constexpr size_t WS_H1 = 280 * MiB;
constexpr size_t WS_XN = WS_H1, WS_AB = WS_H1, WS_QKRAW = WS_H1 + 65 * MiB;
constexpr size_t WS_H1B = 408 * MiB, WS_END = 472 * MiB;
static_assert((size_t)MPAD * DM * 2 <= 65 * MiB && WS_QKRAW + (size_t)MPAD * 768 * 4 <= WS_END && (size_t)BATCH * LTOK * 1024 * 2 <= 65 * MiB, "ws map (H1 region)");
static_assert((size_t)BATCH * HKV * LPA * 128 * 2 <= 17 * MiB && (size_t)BATCH * LTOK * 512 * 2 <= 33 * MiB && WS_T1 + (size_t)BATCH * LTOK * 2 * 512 * 2 <= WS_HID + 256 * MiB, "ws map (HID region)");
constexpr size_t WS_QN = WS_HID + 230 * MiB, WS_KMAX = WS_CTL + 512 * 1024;
constexpr int CW_BAR = 4096;

constexpr int RING_OFF = 0, RING_BYTES = 131072;
constexpr int LDSCTL_OFF = RING_BYTES, MISC_OFF = LDSCTL_OFF + 320;
constexpr int LDS_BYTES = 147456;
static_assert(att::SHM_ATTN <= RING_BYTES && tg::Cfg<13>::LDS_BYTES <= RING_BYTES, "LDS map");

#define GAS __attribute__((address_space(1)))
#define LAS __attribute__((address_space(3)))
typedef unsigned short bf16;
typedef unsigned v4u __attribute__((ext_vector_type(4)));
typedef float f32x4 __attribute__((ext_vector_type(4)));
typedef GAS unsigned gu32;
#define RLX_AGENT __ATOMIC_RELAXED, __HIP_MEMORY_SCOPE_AGENT
#define LDS_WAIT() asm volatile("s_waitcnt lgkmcnt(0)" ::: "memory")
#define VM_WAIT() asm volatile("s_waitcnt vmcnt(0)" ::: "memory")
__device__ __forceinline__ unsigned f2bf(float f) { unsigned u = __builtin_bit_cast(unsigned, f); return (u + 0x7fffu + ((u >> 16) & 1u)) >> 16; }
__device__ __forceinline__ unsigned pk2(float lo, float hi) { return f2bf(lo) | (f2bf(hi) << 16); }

#define XB_TMO      128
#define XB_XCNT(j)  (256  + 64 * (j))
#define XB_XSUB(j)  (1280 + 64 * (j))
#define XB_XGEN(j)  (2304 + 64 * (j))
#define XB_TOP      3328
#define XB_TOPGEN   3392
#define XCD_BAR_WORDS 3456
#define XB_SPIN_CAP (1u << 18)

__device__ __forceinline__ unsigned xb_ld(unsigned* p)              { return __hip_atomic_load(p, __ATOMIC_RELAXED, __HIP_MEMORY_SCOPE_AGENT); }
__device__ __forceinline__ unsigned xb_add(unsigned* p, unsigned v) { return __hip_atomic_fetch_add(p, v, __ATOMIC_RELAXED, __HIP_MEMORY_SCOPE_AGENT); }
__device__ __forceinline__ unsigned xb_xcc_id() { return (unsigned)__builtin_amdgcn_s_getreg((3 << 11) | 20) & 0xFu; }
#define XB_SPIN(cond, bar) do { unsigned _sp = 0; while (cond) { __builtin_amdgcn_s_sleep(1); \
    if ((++_sp & 255u) == 0u) { if (xb_ld(&(bar)[XB_TMO])) break; if (_sp > XB_SPIN_CAP) { atomicAdd(&(bar)[XB_TMO], 1u); break; } } } } while (0)

struct XcdBarrier {
    unsigned* bar; unsigned x;
    volatile LAS unsigned* st;
};

__device__ __forceinline__ XcdBarrier xcd_barrier_post(unsigned* bar, volatile LAS unsigned* st) {
    XcdBarrier b; b.bar = bar; b.x = xb_xcc_id(); b.st = st;
    if (threadIdx.x == 0) (void)xb_add(&bar[XB_XCNT(b.x)], 1u);
    return b;
}
__device__ __forceinline__ void xcd_barrier_complete(unsigned* bar, unsigned x, unsigned& nloc, unsigned& nx) {
    const unsigned G = gridDim.x * gridDim.y * gridDim.z;
    unsigned sum, cnt, mine, sp = 0u;
    for (;;) {
        sum = 0u; cnt = 0u; mine = 0u;
#pragma unroll
        for (unsigned j = 0; j < 16; ++j) { const unsigned c = xb_ld(&bar[XB_XCNT(j)]); sum += c; cnt += (c > 0u) ? 1u : 0u; mine = (j == x) ? c : mine; }
        if (sum == G) break;
        __builtin_amdgcn_s_sleep(1);
        if ((++sp & 255u) == 0u) { if (xb_ld(&bar[XB_TMO])) break; if (sp > XB_SPIN_CAP) { atomicAdd(&bar[XB_TMO], 1u); break; } }
    }
    nloc = mine > 0u ? mine : 1u; nx = cnt > 0u ? cnt : 1u;
}

__device__ __forceinline__ void xcd_barrier(const XcdBarrier& b) {
    asm volatile("s_waitcnt vmcnt(0)" ::: "memory");
    __syncthreads();
    if (threadIdx.x == 0) {
        unsigned* bar = b.bar;
        __builtin_amdgcn_s_waitcnt(0);
        unsigned nloc = b.st[0], nx = b.st[1];
        if (nloc == 0u) { xcd_barrier_complete(bar, b.x, nloc, nx); b.st[0] = nloc; b.st[1] = nx; }
        const unsigned old = xb_add(&bar[XB_XSUB(b.x)], 1u);
        const unsigned gen = old / nloc;
        if (old + 1u == (gen + 1u) * nloc) {
            __builtin_amdgcn_fence(__ATOMIC_RELEASE, "agent");
            asm volatile("s_waitcnt vmcnt(0)" ::: "memory");
            const unsigned og = xb_add(&bar[XB_TOP], 1u);
            const unsigned tg = og / nx;
            if (og + 1u == (tg + 1u) * nx) xb_add(&bar[XB_TOPGEN], 1u);
            else XB_SPIN(xb_ld(&bar[XB_TOPGEN]) == tg, bar);
            __builtin_amdgcn_fence(__ATOMIC_ACQUIRE, "agent");
            xb_add(&bar[XB_XGEN(b.x)], 1u);
            asm volatile("s_waitcnt vmcnt(0)" ::: "memory");
        } else {
            XB_SPIN(xb_ld(&bar[XB_XGEN(b.x)]) == gen, bar);
            __builtin_amdgcn_fence(__ATOMIC_ACQUIRE, "agent");
            asm volatile("s_waitcnt vmcnt(0)" ::: "memory");
        }
    }
    __syncthreads();
}

struct Frame {
    LAS unsigned char* lds;
    volatile LAS unsigned* MISC;
    gu32* ctl;
    int tid, lane, wave;
    int vcu, G;
};

__device__ __forceinline__ float wave_sum(float v) {
#pragma unroll
    for (int o = 1; o < 64; o <<= 1) v += __shfl_xor(v, o);
    return v;
}
__device__ __forceinline__ void p0_transpose_item(const float* W, int K, int N, bf16* WT, const float* gk, LAS float* scr, int item, int lane) {
    const int nblk = N / 32, kb = item / nblk, nb = item % nblk, k0 = 64 * kb, n0 = 32 * nb;
#pragma unroll 8
    for (int i = 0; i < 32; ++i) { const int kk = 2 * i + (lane >> 5); scr[kk * 33 + (lane & 31)] = W[(size_t)(k0 + kk) * N + n0 + (lane & 31)]; }
    LDS_WAIT(); asm volatile("" ::: "memory");
    const int c = lane & 7;
    float gg[8];
#pragma unroll
    for (int e = 0; e < 8; ++e) gg[e] = gk ? gk[k0 + 8 * c + e] : 1.0f;
#pragma unroll
    for (int j = 0; j < 4; ++j) { const int n = (lane >> 3) + 8 * j; const LAS float* s = scr + (8 * c) * 33 + n;
        v4u o; o.x = pk2(s[0 * 33] * gg[0], s[1 * 33] * gg[1]); o.y = pk2(s[2 * 33] * gg[2], s[3 * 33] * gg[3]); o.z = pk2(s[4 * 33] * gg[4], s[5 * 33] * gg[5]); o.w = pk2(s[6 * 33] * gg[6], s[7 * 33] * gg[7]);
        *(GAS v4u*)(WT + (size_t)(n0 + n) * K + k0 + 8 * c) = o; }
    LDS_WAIT(); asm volatile("" ::: "memory");
}
__device__ __forceinline__ void rms_row_to_bf16(int lane, const float* xrow, const float* g, bf16* orow) {
    const GAS f32x4* xr = (const GAS f32x4*)xrow + lane; const GAS f32x4* gr = (const GAS f32x4*)g + lane;
    f32x4 v[4]; float s2 = 0.f;
#pragma unroll
    for (int j = 0; j < 4; ++j) { v[j] = xr[64 * j]; s2 += (v[j].x * v[j].x + v[j].y * v[j].y) + (v[j].z * v[j].z + v[j].w * v[j].w); }
    const float rstd = 1.f / sqrtf(wave_sum(s2) * (1.f / DM) + RMS_EPS);
    GAS unsigned long long* o8 = (GAS unsigned long long*)orow + lane;
#pragma unroll
    for (int j = 0; j < 4; ++j) { const f32x4 gv = gr[64 * j]; o8[64 * j] = (unsigned long long)pk2(v[j].x * rstd * gv.x, v[j].y * rstd * gv.y) | ((unsigned long long)pk2(v[j].z * rstd * gv.z, v[j].w * rstd * gv.w) << 32); }
}
__device__ __forceinline__ void cs2pi(int num, int den, float& c, float& s) {
    const float x = (float)(2 * num) / (float)den; c = cospif(x); s = sinpif(x);
}

struct Args { const float* in[14]; float* out; unsigned char* ws; int ph_lo, ph_hi, li, pad; };

__global__ void __launch_bounds__(NWAVES * 64, 2) hymba_fwd(Args args) {
    extern __shared__ __attribute__((aligned(16))) unsigned char lds[];
    Frame F;
    F.lds = (LAS unsigned char*)lds;
    F.MISC = (volatile LAS unsigned*)(F.lds + MISC_OFF);
    F.tid = threadIdx.x; F.lane = F.tid & 63; F.wave = __builtin_amdgcn_readfirstlane(F.tid >> 6);
    F.G = gridDim.x; { const int bx = blockIdx.x; F.vcu = (F.G % 8 == 0) ? (bx % 8) * (F.G / 8) + bx / 8 : bx; }
    unsigned char* ws = args.ws;
    F.ctl = (gu32*)(ws + WS_CTL);
    const float* x = args.in[0]; const float* meta_tokens = args.in[1]; const float* g_mix = args.in[2]; const float* w_in = args.in[3]; const float* g_q = args.in[4]; const float* g_k = args.in[5];
    const float* w_fourier = args.in[6]; const float* g_attn_out = args.in[7]; const float* g_fourier_out = args.in[8]; const float* w_out = args.in[9]; const float* g_mlp = args.in[10];
    const float* w_up = args.in[11]; const float* w_down = args.in[12]; const float* g_final = args.in[13]; float* out = args.out;
    bf16* WIN_T = (bf16*)(ws + WS_WIN); bf16* WOUT_T = (bf16*)(ws + WS_WOUT); bf16* WUP_T = (bf16*)(ws + WS_WUP); bf16* WDN_T = (bf16*)(ws + WS_WDN);
    float2* ROPE = (float2*)(ws + WS_ROPE); _Float16* W1 = (_Float16*)(ws + WS_W1); _Float16* W2 = (_Float16*)(ws + WS_W2); float2* TW = (float2*)(ws + WS_TW); _Float16* MG = (_Float16*)(ws + WS_MG);
    bf16* MIX = (bf16*)(ws + WS_MIX); bf16* QB = (bf16*)(ws + WS_Q); bf16* KB = (bf16*)(ws + WS_K); bf16* VB = (bf16*)(ws + WS_V); _Float16* UB = (_Float16*)(ws + WS_U); _Float16* T1 = (_Float16*)(ws + WS_T1);
    bf16* XN = (bf16*)(ws + WS_XN); _Float16* AB = (_Float16*)(ws + WS_AB); float* QKRAW = (float*)(ws + WS_QKRAW);
    float* H1 = (float*)(ws + WS_H1); bf16* H1B = (bf16*)(ws + WS_H1B); bf16* HID = (bf16*)(ws + WS_HID);
    float* RSSA = (float*)(ws + WS_RSSA); float* RSSF = (float*)(ws + WS_RSSF); float* RSSM = (float*)(ws + WS_RSSM); float* RSS2 = (float*)(ws + WS_RSS2); float* QN = (float*)(ws + WS_QN); unsigned* KMAX = (unsigned*)(ws + WS_KMAX); float* DUMMY = (float*)(ws + WS_RSS2 + 128 * 1024);

    for (int u = F.tid; u < (LDS_BYTES - LDSCTL_OFF) / 4; u += NWAVES * 64) ((LAS unsigned*)(F.lds + LDSCTL_OFF))[u] = 0u;
    __syncthreads();
    XcdBarrier bar = xcd_barrier_post((unsigned*)(F.ctl + CW_BAR) + args.li * XCD_BAR_WORDS, F.MISC + 8);
#define GRID_BAR() xcd_barrier(bar)
    const int lo = args.ph_lo, hi = args.ph_hi;
#ifndef PROBE_MASK
#define PROBE_MASK 0
#endif
#define PBIT(bit) ((((PROBE_MASK) >> (bit)) & 1) != 0)
#define REP(bit) for (int rep_ = 0; rep_ < (((PROBE_MASK) >> (bit)) & 1) + 1; ++rep_)
#ifndef ONLY_PHASE
#define ONLY_PHASE -1
#endif
#define IN(k) ((ONLY_PHASE < 0 || ONLY_PHASE == (k)) && lo <= (k) && (k) < hi)
#define BOTH(k) (IN(k) && IN((k) + 1))
    const int gw = F.vcu * NWAVES + F.wave, NGW = F.G * NWAVES;
    const int gt = blockIdx.x * (NWAVES * 64) + F.tid, NGT = F.G * NWAVES * 64;

    if (IN(0)) { REP(0) {
        LAS float* scr = (LAS float*)(F.lds + RING_OFF + F.wave * 16384);
        typedef float f32x2l __attribute__((ext_vector_type(2)));
        LAS f32x2l* cs128 = (LAS f32x2l*)(F.lds + RING_OFF + 8 * 16384 - 1024);
        if (F.tid < 128) { float c, s; cs2pi(F.tid, 128, c, s); cs128[F.tid] = (f32x2l){c, s}; }
        __syncthreads();
        constexpr int I_IN = (DM / 64) * (NPROJ / 32), I_OUT = (DM / 64) * (DM / 32), I_UP = (DM / 64) * (DFF / 32), I_DN = (DFF / 64) * (DM / 32);
        constexpr int NITEMS = I_IN + I_OUT + I_UP + I_DN;
        for (int it = gw; it < NITEMS; it += NGW) {
            int r = it;
            if (r < I_IN) { p0_transpose_item(w_in, DM, NPROJ, WIN_T, nullptr, scr, r, F.lane); continue; } r -= I_IN;
            if (r < I_OUT) { const int kb = r / (DM / 32); p0_transpose_item(w_out, DM, DM, WOUT_T, (kb < 8) ? g_attn_out - 0 : g_fourier_out - 512, scr, r, F.lane); continue; } r -= I_OUT;
            if (r < I_UP) { p0_transpose_item(w_up, DM, DFF, WUP_T, g_mlp, scr, r, F.lane); continue; } r -= I_UP;
            p0_transpose_item(w_down, DFF, DM, WDN_T, nullptr, scr, r, F.lane);
        }
        for (int m = gw; m < MPAD; m += NGW) {
            if (m < MR) rms_row_to_bf16(F.lane, x + (size_t)m * DM, g_mix, XN + (size_t)m * DM);
            else if (m < MR + NMETA) rms_row_to_bf16(F.lane, meta_tokens + (size_t)(m - MR) * DM, g_mix, XN + (size_t)m * DM);
            else { GAS unsigned long long* o8 = (GAS unsigned long long*)(XN + (size_t)m * DM) + F.lane;
#pragma unroll
                for (int j = 0; j < 4; ++j) o8[64 * j] = 0ull; }
        }
        for (int i = gt; i < 257 * 32; i += NGT) { const int p = i >> 5, j = i & 31; const float invf = exp2f(-(float)j * (13.287712379549449f / 32.0f)); const float ang = (float)(p - 1) * invf;
            double rv = (double)ang * 0.15915494309189535; rv -= rint(rv); const float xr = (float)(2.0 * rv); ROPE[i] = make_float2(cospif(xr), sinpif(xr)); }
        for (int i = gt; i < 160 * 96; i += NGT) { const int m = i / 96, l1 = i % 96, k1 = m >> 1; float v = 0.f;
            if (l1 < FN1) { float c, s; cs2pi((k1 * l1) % FN1, FN1, c, s); v = (m & 1) ? -s : c; } W1[i] = (_Float16)v; }
        for (int i = gt; i < 416 * 416; i += NGT) { const int m = i / 416, kk = i % 416, k2 = m >> 1, l2 = kk >> 1; float v = 0.f;
            if (k2 < FN2 && l2 < FN2) { float c, s; cs2pi((k2 * l2) % FN2, FN2, c, s); v = (m & 1) ? ((kk & 1) ? -c : s) : ((kk & 1) ? s : c); } W2[i] = (_Float16)v; }
        for (int i = gt; i < FN1 * FN2; i += NGT) { const int k1 = i / FN2, l2 = i % FN2; float c, s; cs2pi(k1 * l2, LTOK, c, s); TW[i] = make_float2(c, s); }
        for (int i = gt; i < 4 * 256 * 128; i += NGT) { const int d = i & 127, kk = (i >> 7) & 255, g = i >> 15, c = kk & 127; const bool isB = kk >= 128; float a = 0.f;
            const float* wf = w_fourier + (size_t)g * 128 * 128 + d;
            for (int m = 0; m < 128; ++m) { const f32x2l t = cs128[(m * c) & 127]; a += (isB ? -t.y : t.x) * wf[m * 128]; }
            MG[i] = (_Float16)(a * 0.088345190f); }
        for (int i = gt; i < 4 * 112 * 16; i += NGT) { const int ch = i & 15, rr = (i >> 4) % 112, img = (i >> 4) / 112; const int row = rr < 48 ? 16 + rr : 16448 + (rr - 48);
            const size_t off = ((size_t)img * LPA + row) * 128 + ch * 8; *(v4u*)(KB + off) = (v4u){0u, 0u, 0u, 0u}; *(v4u*)(VB + off) = (v4u){0u, 0u, 0u, 0u}; }
        __syncthreads(); }
        if (BOTH(0)) GRID_BAR();
    }

    if (IN(1)) {
        pg8::Gemm g{XN, WIN_T, MPAD, NPROJ, DM}; pg8::InProjOrder S; S.init(F.G, (int)blockIdx.x);
        pg8::EpiInProj E{QKRAW, VB, UB};
        pg8::gemm_phase<pg8::EpiInProj, pg8::InProjOrder, true, true>(F.lds + RING_OFF, g, S, E);
        if constexpr (PBIT(1)) pg8::gemm_phase<pg8::EpiInProj, pg8::InProjOrder, true, true>(F.lds + RING_OFF, g, S, E);
        if (BOTH(1)) GRID_BAR();
    }

    if (IN(2)) {
        REP(2) {
        { float km0 = 0.f, km1 = 0.f;
        constexpr float CQ = 0.088388347648318440f * 1.4426950408889634f, MARGIN = 1.0078125f;
        for (int R = gw; R < MR + NMETA; R += NGW) {
            const bool meta = R >= MR; const int b = R >> 14, t = R & (SEQ - 1), jm = R - MR, j = F.lane & 31;
            const int prow = meta ? 0 : (t >> 6) + 1, pcol = meta ? jm + 1 : (t & 63) + 1;
            const float2 cr = ROPE[prow * 32 + j], cc = ROPE[pcol * 32 + j];
            for (int p = meta ? 2 : 0; p < 3; ++p) {
                const int hh = 2 * p + (F.lane >> 5); const float* src = QKRAW + (size_t)R * 768 + hh * 128 + j; const float* gg = (hh < 4 ? g_q : g_k) + j;
                float y0 = src[0], y1 = src[32], y2 = src[64], y3 = src[96];
                float ss = (y0 * y0 + y1 * y1) + (y2 * y2 + y3 * y3);
                ss += __shfl_xor(ss, 1); ss += __shfl_xor(ss, 2); ss += __shfl_xor(ss, 4); ss += __shfl_xor(ss, 8); ss += __shfl_xor(ss, 16);
                const float rstd = (hh < 4 ? CQ : 1.f) / sqrtf(ss * (1.f / 128.f) + RMS_EPS);
                y0 *= rstd * gg[0]; y1 *= rstd * gg[32]; y2 *= rstd * gg[64]; y3 *= rstd * gg[96];
                const float f0 = y0 * cr.x - y1 * cr.y, f1 = y1 * cr.x + y0 * cr.y, f2 = y2 * cc.x - y3 * cc.y, f3 = y3 * cc.x + y2 * cc.y;
                float nn = (f0 * f0 + f1 * f1) + (f2 * f2 + f3 * f3);
                nn += __shfl_xor(nn, 1); nn += __shfl_xor(nn, 2); nn += __shfl_xor(nn, 4); nn += __shfl_xor(nn, 8); nn += __shfl_xor(nn, 16);
                const float nrm = sqrtf(nn) * MARGIN;
                const unsigned o0 = f2bf(f0), o1 = f2bf(f1), o2 = f2bf(f2), o3 = f2bf(f3);
                if (hh < 4) { bf16* q = QB + ((size_t)(b * HQ + hh) * SEQ + t) * 128 + j; q[0] = (bf16)o0; q[32] = (bf16)o1; q[64] = (bf16)o2; q[96] = (bf16)o3;
                    if (j == 0) QN[(size_t)(b * HQ + hh) * SEQ + t] = nrm; }
                else if (!meta) { bf16* k = KB + ((size_t)(b * HKV + hh - 4) * LPA + 64 + t) * 128 + j; k[0] = (bf16)o0; k[32] = (bf16)o1; k[64] = (bf16)o2; k[96] = (bf16)o3;
                    if (b == 0) km0 = fmaxf(km0, nrm); else km1 = fmaxf(km1, nrm); }
                else { km0 = fmaxf(km0, nrm); km1 = fmaxf(km1, nrm);
#pragma unroll
                    for (int bb = 0; bb < 2; ++bb) { bf16* k = KB + ((size_t)(bb * HKV + hh - 4) * LPA + jm) * 128 + j; k[0] = (bf16)o0; k[32] = (bf16)o1; k[64] = (bf16)o2; k[96] = (bf16)o3; } }
            }
        }
        LAS float* kml = (LAS float*)(F.lds + LDSCTL_OFF + 1024);
        if ((F.lane & 31) == 0) { kml[F.wave * 4 + (F.lane >> 5) * 2 + 0] = km0; kml[F.wave * 4 + (F.lane >> 5) * 2 + 1] = km1; }
        __syncthreads();
        if (F.tid < 4) { float m = 0.f;
#pragma unroll
            for (int w = 0; w < 8; ++w) m = fmaxf(m, kml[w * 4 + F.tid]);
            const int kvh = F.tid >> 1, bb = F.tid & 1; atomicMax(KMAX + bb * HKV + kvh, __float_as_uint(m)); }
        __syncthreads(); }
        for (int ui = F.vcu; ui < BATCH * FN2 * 4; ui += F.G) { const int b = ui / (FN2 * 4), nt_ = ui % (FN2 * 4), l2 = nt_ >> 2, c0 = (nt_ & 3) * 128;
            tg::EpiS1 E{TW, T1, b, l2, c0};
            tg::unit<5, tg::EpiS1>(F.lds + RING_OFF, W1, 96, UB + ((size_t)b * LTOK + l2) * 512 + c0, (long)FN2 * 512, FN1, 3, E); }
        }
        if (BOTH(2)) GRID_BAR();
    }

    if (IN(3)) {
#ifndef NO_S2
        REP(3) for (int ui = F.vcu; ui < BATCH * FN1 * 4; ui += F.G) { const int b = ui / (FN1 * 4), r = ui % (FN1 * 4), k1 = r >> 2, q4 = r & 3;
            tg::EpiS2 E{AB, b, k1, q4};
            tg::unit<13, tg::EpiS2>(F.lds + RING_OFF, W2, 416, T1 + ((size_t)(b * FN1 + k1) * (2 * FN2)) * 512 + q4 * 128, 512, 2 * FN2, 13, E); }
#endif
#ifndef NO_ATT
        REP(4) for (int i = 0; i < 2; ++i) { const int un = F.vcu * 2 + i; if (un >= BATCH * HQ * (SEQ / 256)) break;
            const int bh = un >> 6, qb = un & 63, b = bh >> 2, h = bh & 3, kvh = h >> 1;
            att::attn_unit(QB + ((size_t)bh * SEQ + qb * 256) * 128, KB + (size_t)(b * HKV + kvh) * LPA * 128, VB + (size_t)(b * HKV + kvh) * LPA * 128,
                           MIX + ((size_t)b * SEQ + qb * 256) * DM + h * 128, (rep_ ? DUMMY : RSSA) + b * SEQ + qb * 256, QN + (size_t)bh * SEQ + qb * 256, __uint_as_float(KMAX[b * HKV + kvh]), (char*)lds + RING_OFF); }
#endif
        if (BOTH(3)) GRID_BAR();
    }

    if (IN(4)) {
        REP(5) for (int ui = F.vcu; ui < (MR / 128) * 4; ui += F.G) { const int tt = ui >> 2, g = ui & 3, b = tt >> 7, t0 = (tt & 127) * 128;
            tg::EpiCM E{MIX, rep_ ? DUMMY : RSSF, b * SEQ + t0, g};
            tg::unit<4, tg::EpiCM>(F.lds + RING_OFF, AB + ((size_t)b * LTOK + NMETA + t0) * 1024 + g * 256, 1024, MG + (size_t)g * 256 * 128, 128, 256, 8, E); }
        if (BOTH(4)) GRID_BAR();
    }

    if (IN(5)) {
        pg8::Gemm g{MIX, WOUT_T, MR, DM, DM}; pg8::StaticOrder S; S.init(MR, DM, F.G, (int)blockIdx.x);
        LAS float* tab = (LAS float*)(F.lds + LDSCTL_OFF + 1024);
        for (int i = 0; i < 8; ++i) { pg8::Unit u; if (!S.next(i, u)) break;
            if (F.tid < 256) { const int row = u.pm * 256 + F.tid; tab[i * 256 + F.tid] = sqrtf(RSSF[row] * (1.0f / 512.0f) + RMS_EPS) / sqrtf(RSSA[row] * (1.0f / 512.0f) + RMS_EPS); } }
        __syncthreads();
        { pg8::EpiOutProj E{x, H1, H1B, RSSF, RSSM, tab};
        pg8::gemm_phase<pg8::EpiOutProj, pg8::StaticOrder, true, true>(F.lds + RING_OFF, g, S, E); }
        if constexpr (PBIT(6)) { pg8::EpiOutProj E{x, H1, H1B, RSSF, DUMMY, tab};
        pg8::gemm_phase<pg8::EpiOutProj, pg8::StaticOrder, true, true>(F.lds + RING_OFF, g, S, E); }
        if (BOTH(5)) GRID_BAR();
    }
    if (IN(6)) {
        pg8::Gemm g{H1B, WUP_T, MR, DFF, DM}; pg8::StaticOrder S; S.init(MR, DFF, F.G, (int)blockIdx.x);
        pg8::EpiUp E{HID, RSSM};
        pg8::gemm_phase<pg8::EpiUp, pg8::StaticOrder, true, true>(F.lds + RING_OFF, g, S, E);
        if constexpr (PBIT(7)) pg8::gemm_phase<pg8::EpiUp, pg8::StaticOrder, true, true>(F.lds + RING_OFF, g, S, E);
        if (BOTH(6)) GRID_BAR();
    }
    if (IN(7)) {
        pg8::Gemm g{HID, WDN_T, MR, DM, DFF}; pg8::StaticOrder S; S.init(MR, DM, F.G, (int)blockIdx.x);
        { pg8::EpiDown E{H1, out, RSS2};
        pg8::gemm_phase<pg8::EpiDown, pg8::StaticOrder, true, true>(F.lds + RING_OFF, g, S, E); }
        if constexpr (PBIT(8)) { pg8::EpiDown E{H1, out, DUMMY};
        pg8::gemm_phase<pg8::EpiDown, pg8::StaticOrder, true, true>(F.lds + RING_OFF, g, S, E); }
        if (BOTH(7)) GRID_BAR();
    }
    if (IN(8)) {
        for (int m = gw; m < MR; m += NGW) {
            const float rstd = 1.f / sqrtf(RSS2[m] * (1.f / DM) + RMS_EPS);
            GAS f32x4* o = (GAS f32x4*)(out + (size_t)m * DM) + F.lane; const GAS f32x4* gr = (const GAS f32x4*)g_final + F.lane;
#pragma unroll
            for (int j = 0; j < 4; ++j) { const f32x4 v = o[64 * j]; o[64 * j] = v * rstd * gr[64 * j]; }
        }
    }
#undef IN
#undef BOTH
}

extern "C" void kernel_launch(void* const* d_in, const int* in_sizes, int n_in, void* d_out, int out_size, void* d_ws, size_t ws_size, hipStream_t stream) {
    static int grid = 0;
    if (grid == 0) {
        if (n_in != 14 || in_sizes[0] != MR * DM || out_size != MR * DM || ws_size < WS_END) { fprintf(stderr, "kernel_launch: unexpected shapes: n_in %d in0 %d out %d ws %zu (need >= %zu)\n", n_in, n_in > 0 ? in_sizes[0] : -1, out_size, ws_size, (size_t)WS_END); grid = -1; return; }
        int dev = 0, cus = 0, per_cu = 0;
        if (hipGetDevice(&dev) != hipSuccess || hipDeviceGetAttribute(&cus, hipDeviceAttributeMultiprocessorCount, dev) != hipSuccess) { fprintf(stderr, "kernel_launch: device query failed\n"); grid = -1; return; }
        if (hipFuncSetAttribute((const void*)hymba_fwd, hipFuncAttributeMaxDynamicSharedMemorySize, LDS_BYTES) != hipSuccess) { fprintf(stderr, "kernel_launch: hipFuncSetAttribute failed\n"); grid = -1; return; }
        if (hipOccupancyMaxActiveBlocksPerMultiprocessor(&per_cu, (const void*)hymba_fwd, NWAVES * 64, LDS_BYTES) != hipSuccess || per_cu < 1) { fprintf(stderr, "kernel_launch: occupancy query says %d blocks per CU\n", per_cu); (void)hipGetLastError(); grid = -1; return; }
        grid = cus;
    }
    if (grid < 0) return;
    if (hipMemsetAsync((char*)d_ws + WS_CTL, 0, CTL_ZERO_BYTES, stream) != hipSuccess) { fprintf(stderr, "kernel_launch: memset failed\n"); return; }
    Args a{};
    for (int i = 0; i < 14; ++i) a.in[i] = (const float*)d_in[i];
    a.out = (float*)d_out; a.ws = (unsigned char*)d_ws;
    for (int li = 0; li < N_LAUNCHES; ++li) {
        a.ph_lo = (N_LAUNCHES == 1) ? 0 : li; a.ph_hi = (N_LAUNCHES == 1) ? N_PHASES : li + 1; a.li = li; a.pad = 0;
        hipLaunchKernelGGL(hymba_fwd, dim3(grid), dim3(NWAVES * 64), LDS_BYTES, stream, a);
        const hipError_t le = hipPeekAtLastError();
        if (le != hipSuccess) { fprintf(stderr, "kernel_launch: launch %d failed: %s\n", li, hipGetErrorName(le)); break; }
    }
}
```
